# Optimizing an MI355X kernel written in HIP

```python
import jax, jax.numpy as jnp
from jax import lax
import numpy as np

D_MODEL = 2048
BATCH = 4
SEQ = 2048
DEPTH = 1
DEC_BATCH = 128
DEC_SEQ = 1
PAST_LEN = 16384
PAGE_SIZE = 128

RWKV_HEAD = 64
RWKV_WIDTH = D_MODEL // 2
RWKV_HEADS = RWKV_WIDTH // RWKV_HEAD
DECAY_LORA = 64
AAA_LORA = 64
GATE_LORA = 160
P_RWKV = 3 * RWKV_WIDTH + DECAY_LORA + AAA_LORA + GATE_LORA
RWKV_GN_EPS = 64e-5
RET_HEADS = 8
RET_DK = 128
RET_DV = 128
RET_WIDTH_QK = RET_HEADS * RET_DK
RET_WIDTH_V = RET_HEADS * RET_DV
RET_CHUNK = 128
ROPE_BASE = 10000.0
RET_GN_EPS = 1e-5
N_IN = P_RWKV + 2 * RET_WIDTH_QK + 2 * RET_WIDTH_V + 2 * D_MODEL
D_FF = 5632
CONV_W = 3
LN_EPS = 1e-5
ALPHA = (2.0 * DEPTH) ** 0.25
BETA = (8.0 * DEPTH) ** -0.25

kernel_name = "hybrid_rwkv7_retention_convffn_step"


def _split(t, sizes):
    return jnp.split(t, [int(s) for s in np.cumsum(sizes)[:-1]], axis=-1)


def _layer_norm(x, w, b):
    xf = x.astype(jnp.float32)
    mu = xf.mean(-1, keepdims=True)
    var = jnp.mean(jnp.square(xf - mu), -1, keepdims=True)
    return ((xf - mu) * lax.rsqrt(var + LN_EPS) * w + b).astype(x.dtype)


def _head_norm(x, w, b, eps):
    xf = x.astype(jnp.float32)
    mu = xf.mean(-1, keepdims=True)
    var = jnp.mean(jnp.square(xf - mu), -1, keepdims=True)
    y = ((xf - mu) * lax.rsqrt(var + eps)).reshape(x.shape[0], x.shape[1], -1)
    return y * w + b


def _rope(t, pos):
    half = t.shape[-1] // 2
    inv = ROPE_BASE ** (-jnp.arange(half, dtype=jnp.float32) / half)
    ang = pos[:, None] * inv[None, :]
    cos = jnp.cos(ang)[None, :, None, :]
    sin = jnp.sin(ang)[None, :, None, :]
    t1, t2 = t[..., :half], t[..., half:]
    return jnp.concatenate([t1 * cos - t2 * sin, t1 * sin + t2 * cos], axis=-1)


def _rwkv7(z, shift_prev, s0, mu, w0, w_decay_up, a0, w_aaa_up, w_gate_up, k_k, k_a, r_k, lnx_w, lnx_b):
    B, L, _ = z.shape
    H, N = RWKV_HEADS, RWKV_HEAD
    prev = jnp.concatenate([shift_prev[:, None].astype(z.dtype), z[:, :-1]], axis=1)
    zs = z + mu * (prev - z)
    r, k, v, wd, ad, gd = _split(zs, (RWKV_WIDTH, RWKV_WIDTH, RWKV_WIDTH, DECAY_LORA, AAA_LORA, GATE_LORA))
    w = -jax.nn.softplus(-(w0 + jnp.tanh(wd) @ w_decay_up)) - 0.5
    decay = jnp.exp(-jnp.exp(w.astype(jnp.float32)))
    a = jax.nn.sigmoid(a0 + ad @ w_aaa_up)
    g = jax.nn.sigmoid(gd) @ w_gate_up
    kk = (k * k_k).astype(jnp.float32).reshape(B, L, H, N)
    kk = kk / jnp.maximum(jnp.linalg.norm(kk, axis=-1, keepdims=True), 1e-12)
    k = k * (1.0 + (a - 1.0) * k_a)
    hd = lambda t: t.astype(jnp.float32).reshape(B, L, H, N)
    rh, kh, vh, ah, wh = hd(r), hd(k), hd(v), hd(a), hd(decay)
    tm = lambda t: t.transpose(1, 0, 2, 3)

    def step(S, inp):
        r_t, w_t, k_t, v_t, kk_t, a_t = inp
        sa = jnp.einsum('bhvk,bhk->bhv', S, -kk_t)
        S = (S * w_t[:, :, None, :] + sa[..., None] * (kk_t * a_t)[:, :, None, :]
             + v_t[..., None] * k_t[:, :, None, :])
        return S, jnp.einsum('bhvk,bhk->bhv', S, r_t)

    S, o = lax.scan(step, s0.astype(jnp.float32), (tm(rh), tm(wh), tm(kh), tm(vh), tm(kk), tm(ah)))
    o = _head_norm(o.transpose(1, 0, 2, 3), lnx_w, lnx_b, RWKV_GN_EPS)
    bonus = (jnp.sum(rh * kh * r_k, axis=-1, keepdims=True) * vh).reshape(B, L, -1)
    y = (o + bonus) * g
    return y, S, z[:, -1]


def _retention(q, k, v, s0, pos0):
    B, L, _ = q.shape
    H = RET_HEADS
    pos = pos0 + jnp.arange(L, dtype=jnp.float32)
    qh = _rope(q.astype(jnp.float32).reshape(B, L, H, RET_DK), pos)
    kh = _rope(k.astype(jnp.float32).reshape(B, L, H, RET_DK), pos) * (RET_DK ** -0.5)
    vh = v.astype(jnp.float32).reshape(B, L, H, RET_DV)
    C = RET_CHUNK if L % RET_CHUNK == 0 else L
    n = L // C
    blocks = lambda t: t.reshape(B, n, C, H, t.shape[-1]).transpose(1, 0, 3, 2, 4)
    log_g = jnp.log1p(-jnp.exp2(-5.0 - jnp.arange(H, dtype=jnp.float32)))
    i = jnp.arange(C, dtype=jnp.float32)
    rel = i[:, None] - i[None, :]
    intra = jnp.where(rel >= 0, jnp.exp(log_g[:, None, None] * jnp.maximum(rel, 0.0)), 0.0)
    q_decay = jnp.exp(log_g[:, None] * (i + 1.0))
    k_decay = jnp.exp(log_g[:, None] * (C - 1.0 - i))
    blk_decay = jnp.exp(log_g * C)

    def step(S, blk):
        qb, kb, vb = blk
        scores = jnp.einsum('bhid,bhjd->bhij', qb, kb) * intra
        o = (jnp.einsum('bhij,bhjv->bhiv', scores, vb)
             + jnp.einsum('bhid,bhdv->bhiv', qb, S) * q_decay[:, :, None])
        S = S * blk_decay[:, None, None] + jnp.einsum('bhjd,bhjv->bhdv', kb * k_decay[:, :, None], vb)
        return S, o

    S, o = lax.scan(step, s0.astype(jnp.float32), (blocks(qh), blocks(kh), blocks(vh)))
    o = o.transpose(1, 0, 3, 2, 4).reshape(B, L, H, RET_DV)
    return o, S


def _conv_ffn(u, conv_prev, w_up, conv_w, conv_b, w_down):
    h = u @ w_up
    L = h.shape[1]
    hp = jnp.concatenate([conv_prev.astype(h.dtype), h], axis=1)
    y = conv_b + sum(conv_w[j] * hp[:, j:j + L] for j in range(CONV_W))
    a, b = jnp.split(y, 2, axis=-1)
    return (jax.nn.silu(a) * b) @ w_down, hp[:, -(CONV_W - 1):]


def _layer(x, c, s_wkv, s_shift, s_ret, s_conv, pos0, lw):
    (w_ada, b_ada, w_in, shift_mu, w0, w_decay_up, a0, w_aaa_up, w_gate_up, k_k, k_a, r_k,
     lnx_w, lnx_b, ret_gn_w, ret_gn_b, w_branch_a, w_branch_b, w_out, ln1_w, ln1_b,
     w_up, conv_w, conv_b, w_down, ln2_w, ln2_b) = lw
    ada = (c @ w_ada + b_ada)[:, None, :]
    sh1, sc1, g1, sh2, sc2, g2 = jnp.split(ada, 6, axis=-1)
    u = x * (1.0 + sc1) + sh1
    proj = u @ w_in
    z_rwkv, q, k, v, ret_g, gate_a, gate_b = _split(
        proj, (P_RWKV, RET_WIDTH_QK, RET_WIDTH_QK, RET_WIDTH_V, RET_WIDTH_V, D_MODEL, D_MODEL))
    ya, wkv_new, shift_new = _rwkv7(z_rwkv, s_shift, s_wkv, shift_mu, w0, w_decay_up, a0, w_aaa_up,
                                    w_gate_up, k_k, k_a, r_k, lnx_w, lnx_b)
    ob, ret_new = _retention(q, k, v, s_ret, pos0)
    yb = _head_norm(ob, ret_gn_w, ret_gn_b, RET_GN_EPS) * jax.nn.silu(ret_g)
    merged = (jax.nn.sigmoid(gate_a) * (ya.astype(x.dtype) @ w_branch_a)
              + jax.nn.sigmoid(gate_b) * (yb.astype(x.dtype) @ w_branch_b))
    x1 = _layer_norm(ALPHA * x + g1 * (merged @ w_out), ln1_w, ln1_b)
    u2 = x1 * (1.0 + sc2) + sh2
    f, conv_new = _conv_ffn(u2, s_conv, w_up, conv_w, conv_b, w_down)
    x2 = _layer_norm(ALPHA * x1 + g2 * f, ln2_w, ln2_b)
    return x2, wkv_new, shift_new, ret_new, conv_new


def setup_inputs(seed: int = 0) -> dict:
    key = jax.random.key(seed)
    ks = iter(jax.random.split(key, 40))
    nrm = lambda shape, s: jax.random.normal(next(ks), shape, jnp.float32) * s
    D, F2 = D_MODEL, 2 * D_FF
    return {
        "x_prompt": nrm((BATCH, SEQ, D), 1.0),
        "x_sample": nrm((DEC_BATCH, DEC_SEQ, D), 1.0),
        "c_prompt": nrm((BATCH, D), 1.0),
        "c_sample": nrm((DEC_BATCH, D), 1.0),
        "state_wkv": nrm((DEPTH, DEC_BATCH, RWKV_HEADS, RWKV_HEAD, RWKV_HEAD), 0.1),
        "state_shift": nrm((DEPTH, DEC_BATCH, P_RWKV), 1.0),
        "state_ret": nrm((DEPTH, DEC_BATCH, RET_HEADS, RET_DK, RET_DV), 0.1),
        "state_conv": nrm((DEPTH, DEC_BATCH, CONV_W - 1, F2), 1.0),
        "w_ada": nrm((DEPTH, D, 6 * D), 0.1 * D ** -0.5),
        "b_ada": nrm((DEPTH, 6 * D), 0.01),
        "w_in": nrm((DEPTH, D, N_IN), D ** -0.5),
        "shift_mu": jax.random.uniform(next(ks), (DEPTH, P_RWKV), jnp.float32),
        "w0": jax.random.uniform(next(ks), (DEPTH, RWKV_WIDTH), jnp.float32, -6.0, -1.0),
        "w_decay_up": nrm((DEPTH, DECAY_LORA, RWKV_WIDTH), 0.1),
        "a0": nrm((DEPTH, RWKV_WIDTH), 0.1),
        "w_aaa_up": nrm((DEPTH, AAA_LORA, RWKV_WIDTH), 0.1),
        "w_gate_up": nrm((DEPTH, GATE_LORA, RWKV_WIDTH), GATE_LORA ** -0.5),
        "k_k": 0.85 + nrm((DEPTH, RWKV_WIDTH), 0.05),
        "k_a": 1.0 + nrm((DEPTH, RWKV_WIDTH), 0.05),
        "r_k": nrm((DEPTH, RWKV_HEADS, RWKV_HEAD), 0.1),
        "lnx_w": 1.0 + nrm((DEPTH, RWKV_WIDTH), 0.05),
        "lnx_b": nrm((DEPTH, RWKV_WIDTH), 0.01),
        "ret_gn_w": 1.0 + nrm((DEPTH, RET_WIDTH_V), 0.05),
        "ret_gn_b": nrm((DEPTH, RET_WIDTH_V), 0.01),
        "w_branch_a": nrm((DEPTH, RWKV_WIDTH, D), RWKV_WIDTH ** -0.5),
        "w_branch_b": nrm((DEPTH, RET_WIDTH_V, D), RET_WIDTH_V ** -0.5),
        "w_out": nrm((DEPTH, D, D), BETA * D ** -0.5),
        "ln1_w": 1.0 + nrm((DEPTH, D), 0.05),
        "ln1_b": nrm((DEPTH, D), 0.01),
        "w_up": nrm((DEPTH, D, F2), D ** -0.5),
        "conv_w": nrm((DEPTH, CONV_W, F2), CONV_W ** -0.5),
        "conv_b": nrm((DEPTH, F2), 0.01),
        "w_down": nrm((DEPTH, D_FF, D), BETA * D_FF ** -0.5),
        "ln2_w": 1.0 + nrm((DEPTH, D), 0.05),
        "ln2_b": nrm((DEPTH, D), 0.01),
    }


def reference(x_prompt, x_sample, c_prompt, c_sample, state_wkv, state_shift, state_ret, state_conv,
              w_ada, b_ada, w_in, shift_mu, w0, w_decay_up, a0, w_aaa_up, w_gate_up, k_k, k_a, r_k,
              lnx_w, lnx_b, ret_gn_w, ret_gn_b, w_branch_a, w_branch_b, w_out, ln1_w, ln1_b,
              w_up, conv_w, conv_b, w_down, ln2_w, ln2_b):
    B = x_prompt.shape[0]
    f32 = jnp.float32
    xp, xs = x_prompt, x_sample
    wkv_p, shift_p, ret_p, conv_p = [], [], [], []
    wkv_s, shift_s, ret_s, conv_s = [], [], [], []
    for l in range(DEPTH):
        lw = (w_ada[l], b_ada[l], w_in[l], shift_mu[l], w0[l], w_decay_up[l], a0[l], w_aaa_up[l],
              w_gate_up[l], k_k[l], k_a[l], r_k[l], lnx_w[l], lnx_b[l], ret_gn_w[l], ret_gn_b[l],
              w_branch_a[l], w_branch_b[l], w_out[l], ln1_w[l], ln1_b[l], w_up[l], conv_w[l],
              conv_b[l], w_down[l], ln2_w[l], ln2_b[l])
        xp, a1, a2, a3, a4 = _layer(
            xp, c_prompt,
            jnp.zeros((B, RWKV_HEADS, RWKV_HEAD, RWKV_HEAD), f32),
            jnp.zeros((B, P_RWKV), f32),
            jnp.zeros((B, RET_HEADS, RET_DK, RET_DV), f32),
            jnp.zeros((B, CONV_W - 1, 2 * D_FF), f32),
            0, lw)
        xs, b1, b2, b3, b4 = _layer(xs, c_sample, state_wkv[l], state_shift[l], state_ret[l],
                                    state_conv[l], PAST_LEN, lw)
        wkv_p.append(a1); shift_p.append(a2); ret_p.append(a3); conv_p.append(a4)
        wkv_s.append(b1); shift_s.append(b2); ret_s.append(b3); conv_s.append(b4)
    st = lambda lst, ref: jnp.stack(lst, axis=0).astype(ref.dtype)
    return (xp, xs,
            st(wkv_p, state_wkv), st(shift_p, state_shift), st(ret_p, state_ret), st(conv_p, state_conv),
            st(wkv_s, state_wkv), st(shift_s, state_shift), st(ret_s, state_ret), st(conv_s, state_conv))
```

```cpp
#include <hip/hip_runtime.h>
#include <hip/hip_cooperative_groups.h>
#include <cstdio>
namespace cg = cooperative_groups;
#define MULTI 0
namespace pg8 {
#define PG8_LAS __attribute__((address_space(3)))
typedef unsigned short bf16_t;
typedef short bf16x8 __attribute__((ext_vector_type(8)));
typedef float f32x4 __attribute__((ext_vector_type(4)));
typedef unsigned u32x4 __attribute__((ext_vector_type(4)));
constexpr int BM = 256, BK = 64, HALF = 128, HTB = HALF * BK * 2  , STAGE_BYTES = 8 * HTB, NXCD = 8, WGM = 8;

__host__ __device__ __forceinline__ int lds_byte(int r, int c) { const int st = (r >> 4) * 2 + (c >> 5), rr = r & 15, cc = c & 31, ob = rr * 64 + cc * 2; return st * 1024 + (ob ^ (((ob >> 9) & 1) << 5)); }
__host__ __device__ __forceinline__ void stage_rc(int b, int& R, int& C) { const int st = b / 1024, sb = b % 1024, swz = sb ^ (((sb >> 9) & 1) << 5); R = (st >> 1) * 16 + swz / 64; C = (st & 1) * 32 + (swz % 64) / 2; }
__host__ __device__ __forceinline__ int perm32(int rho) { const int n = rho >> 4, i = rho & 15; return 8 * (i >> 2) + 4 * n + (i & 3); }

struct Unit { int pm, pn; };
struct Gemm { const bf16_t* A; const bf16_t* Bt; int M, N, K; };

struct StaticOrder {
    int nM, nN, nwg, G, c;
    __host__ __device__ void init(int M, int N, int G_, int c_) { nM = M / BM; nN = N / BM; nwg = nM * nN; G = G_; c = c_; }
    __host__ __device__ bool next(int i, Unit& u) const {
        const long L = (long)i * G + c; if (L >= nwg) return false;
        int wgid = (int)L; { const int q = nwg / NXCD, r = nwg % NXCD, xcd = wgid % NXCD, off = wgid / NXCD; wgid = (xcd < r ? xcd * (q + 1) : r * (q + 1) + (xcd - r) * q) + off; }
        const int nig = WGM * nN, gid = wgid / nig, fm = gid * WGM, gsz = (nM - fm) < WGM ? (nM - fm) : WGM;
        u.pm = fm + ((wgid % nig) % gsz); u.pn = (wgid % nig) / gsz; return true;
    }
    __device__ __forceinline__ void a_ready(const Unit&) const {}
    __device__ __forceinline__ void done(const Unit&) const {}
};
__device__ __forceinline__ unsigned cvt_pk_bf16(float lo, float hi) { unsigned r; asm volatile("v_cvt_pk_bf16_f32 %0, %1, %2" : "=v"(r) : "v"(lo), "v"(hi)); return r; }
typedef float f32x2 __attribute__((ext_vector_type(2)));
template <class Epi, class Sched, bool STAMP = false>
__device__ __forceinline__ void gemm_phase(PG8_LAS unsigned char* lds, const Gemm g, const Sched& S, const Epi& E, unsigned long long* stamps) {
    const int tid = threadIdx.x, wid = __builtin_amdgcn_readfirstlane(tid >> 6), lane = tid & 63, wr = wid >> 2, wc = wid & 3, fr = lane & 15, fq = lane >> 4;
    const int K = g.K, nt = K / BK;
    int ts_lo = 0, ts_hi = 0, nts = 0; const unsigned long long rt_entry = STAMP ? (unsigned long long)wall_clock64() : 0ull;
#define PG8_STAMP() do { if (STAMP && wid == 0 && nts < 64) { const unsigned long long _c = (unsigned long long)clock64(); \
        ts_lo = (lane == nts) ? (int)(unsigned)_c : ts_lo; ts_hi = (lane == nts) ? (int)(unsigned)(_c >> 32) : ts_hi; ++nts; } } while (0)
    PG8_STAMP();
    unsigned voffA[2], voffB[2];
#pragma unroll
    for (int i = 0; i < 2; ++i) { int R, C; stage_rc(tid * 16 + i * 8192, R, C); const int Rb = Epi::PERM ? ((R & ~31) + perm32(R & 31)) : R;
        voffA[i] = (unsigned)(R * K + C) * 2u; voffB[i] = (unsigned)(Rb * K + C) * 2u; }
    const size_t kstep = (size_t)(BK * 2);
    const size_t hstep = (size_t)HALF * K * 2;
    const size_t tstep = 2 * hstep;
    const unsigned ldsw = (unsigned)wid * 1024u;
    const int aoff = lds_byte(wr * 64 + fr, fq * 8), boff = lds_byte(wc * 32 + fr, fq * 8);
#define PG8_SA(b, h) (((b) * 2 + (h)) * HTB)
#define PG8_SB(b, h) ((4 + (b) * 2 + (h)) * HTB)
#define PG8_STAGE(bufoff, gbase, voff) do { _Pragma("unroll") for (int _i = 0; _i < 2; ++_i) \
        __builtin_amdgcn_global_load_lds((const unsigned*)((const char*)(gbase) + (voff)[_i]), (PG8_LAS unsigned*)(lds + (bufoff) + ldsw + _i * 8192), 16, 0, 0); } while (0)
#define PG8_LDA(dst, b, h) do { _Pragma("unroll") for (int m = 0; m < 4; ++m) _Pragma("unroll") for (int k = 0; k < 2; ++k) dst[m][k] = *(const PG8_LAS bf16x8*)(lds + PG8_SA(b, h) + aoff + m * 2048 + k * 1024); } while (0)
#define PG8_LDB(dst, b, h) do { _Pragma("unroll") for (int n = 0; n < 2; ++n) _Pragma("unroll") for (int k = 0; k < 2; ++k) dst[n][k] = *(const PG8_LAS bf16x8*)(lds + PG8_SB(b, h) + boff + n * 2048 + k * 1024); } while (0)
#define PG8_MMA(ai, bj, At, Bt) do { __builtin_amdgcn_s_setprio(1); _Pragma("unroll") for (int m = 0; m < 4; ++m) _Pragma("unroll") for (int n = 0; n < 2; ++n) _Pragma("unroll") for (int k = 0; k < 2; ++k) \
        acc[ai][bj][m][n] = __builtin_amdgcn_mfma_f32_16x16x32_bf16(Bt[n][k], At[m][k], acc[ai][bj][m][n], 0, 0, 0); __builtin_amdgcn_s_setprio(0); } while (0)
#define PG8_WAIT_V(n) asm volatile("s_waitcnt vmcnt(" #n ")" ::: "memory")
#define PG8_WAIT_L(n) asm volatile("s_waitcnt lgkmcnt(" #n ")" ::: "memory")
#define PG8_BAR __builtin_amdgcn_s_barrier()
#define PG8_SCHED __builtin_amdgcn_sched_barrier(0)
    Unit cur, nxt; int ui = 0;
    if (!S.next(0, cur)) return;
    f32x4 acc[2][2][4][2];
#pragma unroll
    for (int a = 0; a < 2; ++a)
#pragma unroll
        for (int b = 0; b < 2; ++b)
#pragma unroll
            for (int m = 0; m < 4; ++m)
#pragma unroll
                for (int n = 0; n < 2; ++n) acc[a][b][m][n] = (f32x4){0.f, 0.f, 0.f, 0.f};
    bf16x8 At[4][2], B0[2][2], B1[2][2];
    const char* cA = (const char*)g.A + (size_t)cur.pm * tstep; const char* cB = (const char*)g.Bt + (size_t)cur.pn * tstep;
    S.a_ready(cur);
    PG8_STAGE(PG8_SB(0, 0), cB, voffB); PG8_STAGE(PG8_SA(0, 0), cA, voffA); PG8_STAGE(PG8_SB(0, 1), cB + hstep, voffB); PG8_STAGE(PG8_SA(0, 1), cA + hstep, voffA);
    if (wr == 1) PG8_BAR;
    PG8_WAIT_V(4); PG8_BAR;
    PG8_STAGE(PG8_SB(1, 0), cB + kstep, voffB); PG8_STAGE(PG8_SA(1, 0), cA + kstep, voffA); PG8_STAGE(PG8_SB(1, 1), cB + hstep + kstep, voffB);
    PG8_WAIT_V(6); PG8_BAR;
    PG8_STAMP();
    for (;;) {
        const bool has_next = S.next(ui + 1, nxt);
        const char* nA = has_next ? (const char*)g.A + (size_t)nxt.pm * tstep : cA; const char* nB = has_next ? (const char*)g.Bt + (size_t)nxt.pn * tstep : cB;
        for (int t = 0; t < nt; t += 2) {
            const bool last = (t == nt - 2);
            const char* a1 = cA + (size_t)(t + 1) * kstep;
            const char* a2 = last ? nA : cA + (size_t)(t + 2) * kstep; const char* b2 = last ? nB : cB + (size_t)(t + 2) * kstep;
            const char* a3 = a2 + kstep; const char* b3 = b2 + kstep;
            if (last && has_next) S.a_ready(nxt);
            PG8_LDB(B0, 0, 0); PG8_SCHED; PG8_LDA(At, 0, 0); PG8_STAGE(PG8_SA(1, 1), a1 + hstep, voffA);
            PG8_WAIT_L(8); PG8_BAR; PG8_WAIT_L(0); PG8_MMA(0, 0, At, B0); PG8_BAR; PG8_SCHED;
            PG8_LDB(B1, 0, 1); PG8_STAGE(PG8_SB(0, 0), b2, voffB);
            PG8_BAR; PG8_WAIT_L(0); PG8_MMA(0, 1, At, B1); PG8_BAR;
            PG8_LDA(At, 0, 1); PG8_STAGE(PG8_SA(0, 0), a2, voffA);
            PG8_BAR; PG8_WAIT_L(0); PG8_MMA(1, 0, At, B0); PG8_BAR; PG8_SCHED;
            PG8_STAGE(PG8_SB(0, 1), b2 + hstep, voffB);
            PG8_WAIT_V(6); PG8_BAR; PG8_MMA(1, 1, At, B1); PG8_BAR;
            PG8_LDB(B0, 1, 0); PG8_SCHED; PG8_LDA(At, 1, 0); PG8_STAGE(PG8_SA(0, 1), a2 + hstep, voffA);
            PG8_WAIT_L(8); PG8_BAR; PG8_WAIT_L(0); PG8_MMA(0, 0, At, B0); PG8_BAR; PG8_SCHED;
            PG8_LDB(B1, 1, 1); PG8_STAGE(PG8_SB(1, 0), b3, voffB);
            PG8_BAR; PG8_WAIT_L(0); PG8_MMA(0, 1, At, B1); PG8_BAR;
            PG8_LDA(At, 1, 1); PG8_STAGE(PG8_SA(1, 0), a3, voffA);
            PG8_BAR; PG8_WAIT_L(0); PG8_MMA(1, 0, At, B0); PG8_BAR; PG8_SCHED;
            PG8_STAGE(PG8_SB(1, 1), b3 + hstep, voffB);
            PG8_WAIT_V(6); PG8_BAR; PG8_MMA(1, 1, At, B1); PG8_BAR;
        }
        PG8_STAMP();
        if constexpr (!Epi::AFTER_DRAIN) { E(acc, cur, wr, wc, fr, fq); S.done(cur); }
        PG8_STAMP();
        if (!has_next) break;
#pragma unroll
        for (int a = 0; a < 2; ++a)
#pragma unroll
            for (int b = 0; b < 2; ++b)
#pragma unroll
                for (int m = 0; m < 4; ++m)
#pragma unroll
                    for (int n = 0; n < 2; ++n) acc[a][b][m][n] = (f32x4){0.f, 0.f, 0.f, 0.f};
        cur = nxt; cA = nA; cB = nB; ++ui;
    }
    PG8_WAIT_V(0);
    if (wr == 0) PG8_BAR;
    PG8_BAR;
    if constexpr (Epi::AFTER_DRAIN) { E.fused(acc, cur, wr, wc, fr, fq, lds, wid, lane); S.done(cur); }
    PG8_STAMP();
    if (STAMP && wid == 0) { stamps[lane] = lane < nts ? (((unsigned long long)(unsigned)ts_hi << 32) | (unsigned)ts_lo) : 0ull;
        if (lane == 62) stamps[62] = rt_entry; if (lane == 63) stamps[63] = (unsigned long long)wall_clock64(); }
#undef PG8_STAMP
#undef PG8_SA
#undef PG8_SB
#undef PG8_STAGE
#undef PG8_LDA
#undef PG8_LDB
#undef PG8_MMA
#undef PG8_WAIT_V
#undef PG8_WAIT_L
#undef PG8_BAR
#undef PG8_SCHED
}
}

using pg8::bf16_t; using pg8::f32x4; using pg8::u32x4; using pg8::Unit; using pg8::BM; using pg8::HALF; using pg8::cvt_pk_bf16; using pg8::bf16x8;
typedef unsigned u32x2 __attribute__((ext_vector_type(2)));

#ifndef MULTI
#define MULTI 0
#endif

constexpr int D = 2048, SEQ = 2048, NB = 4, NS = 128;
constexpr int MPR = NB * SEQ;
constexpr int MTOK = MPR + NS;
constexpr int MP = 8448;
constexpr int RW = 1024, PRW = 3360;
constexpr int NINP = 11776;
constexpr int C_Q = 3584, C_K = 4608, C_V = 5632, C_RG = 6656, C_GA = 7680, C_GB = 9728;
constexpr int F2 = 11264, DFF = 5632;
constexpr int KL = 384, NL = 3072;
constexpr int NADA = 12288;
constexpr float ALPHA = 1.189207115002721f;
constexpr int NPHASE = 15;
constexpr int LDS_BYTES = 131072 + 1024;

constexpr size_t O_YP = 0;
constexpr size_t O_YS = O_YP + (size_t)MPR * D;
constexpr size_t O_WKVP = O_YS + (size_t)NS * D;
constexpr size_t O_SHIFTP = O_WKVP + (size_t)NB * 16 * 64 * 64;
constexpr size_t O_RETP = O_SHIFTP + (size_t)NB * PRW;
constexpr size_t O_CONVP = O_RETP + (size_t)NB * 8 * 128 * 128;
constexpr size_t O_WKVS = O_CONVP + (size_t)NB * 2 * F2;
constexpr size_t O_SHIFTS = O_WKVS + (size_t)NS * 16 * 64 * 64;
constexpr size_t O_RETS = O_SHIFTS + (size_t)NS * PRW;
constexpr size_t O_CONVS = O_RETS + (size_t)NS * 8 * 128 * 128;
constexpr size_t O_END = O_CONVS + (size_t)NS * 2 * F2;

constexpr size_t al256(size_t x) { return (x + 255) & ~(size_t)255; }
constexpr size_t WS_WIN = 0;
constexpr size_t WS_WUP = al256(WS_WIN + (size_t)NINP * D * 2);
constexpr size_t WS_WDOWN = al256(WS_WUP + (size_t)F2 * D * 2);
constexpr size_t WS_WOUT = al256(WS_WDOWN + (size_t)D * DFF * 2);
constexpr size_t WS_WBA = al256(WS_WOUT + (size_t)D * D * 2);
constexpr size_t WS_WBB = al256(WS_WBA + (size_t)D * RW * 2);
constexpr size_t WS_WLORA = al256(WS_WBB + (size_t)D * RW * 2);
constexpr size_t WS_ADA = al256(WS_WLORA + (size_t)NL * KL * 2);
constexpr size_t WS_AADA = al256(WS_ADA + (size_t)132 * NADA * 4);
constexpr size_t WS_ROPE = al256(WS_AADA + (size_t)256 * D * 2);
constexpr size_t WS_BONUS = al256(WS_ROPE + (size_t)2049 * 64 * 4 * 2);
constexpr size_t WS_ALORA = al256(WS_BONUS + (size_t)MTOK * 16 * 4);
constexpr size_t WS_RC = al256(WS_ALORA + (size_t)MP * KL * 2);
constexpr size_t WS_RD = al256(WS_RC + (size_t)MP * D * 2);
constexpr size_t WS_RA = al256(WS_RD + (size_t)MP * D * 2);
constexpr size_t WS_RB = al256(WS_RA + (size_t)MP * NINP * 2);
constexpr size_t WS_END = al256(WS_RB + (size_t)MP * DFF * 2);

struct Params { const float* in[35]; float* out; unsigned char* ws; int ph_lo, ph_hi; };

enum { I_XP = 0, I_XS, I_CP, I_CS, I_SWKV, I_SSHIFT, I_SRET, I_SCONV, I_WADA, I_BADA, I_WIN, I_MU, I_W0, I_WDEC, I_A0, I_WAAA, I_WGATE, I_KK, I_KA, I_RK,
       I_LNXW, I_LNXB, I_RGNW, I_RGNB, I_WBA, I_WBB, I_WOUT, I_LN1W, I_LN1B, I_WUP, I_CONVW, I_CONVB, I_WDOWN, I_LN2W, I_LN2B };

__device__ __forceinline__ float bf2f(bf16_t v) { return __uint_as_float(((unsigned)v) << 16); }
__device__ __forceinline__ bf16_t f2bf(float f) { unsigned u = __float_as_uint(f); u += 0x7FFFu + ((u >> 16) & 1u); return (bf16_t)(u >> 16); }
__device__ __forceinline__ float lo_bf(unsigned w) { return __uint_as_float(w << 16); }
__device__ __forceinline__ float hi_bf(unsigned w) { return __uint_as_float(w & 0xffff0000u); }
__device__ __forceinline__ float wave_sum(float x) {
#pragma unroll
    for (int o = 32; o >= 1; o >>= 1) x += __shfl_xor(x, o);
    return x;
}
__device__ __forceinline__ float sigmoidf_(float x) { return 1.0f / (1.0f + __expf(-x)); }
__device__ __forceinline__ int ada_row(int row) { return row < MPR ? (row >> 11) : 4 + (row - MPR); }

static __device__ __forceinline__ void transpose_job(const float* __restrict__ W, int K, int N, bf16_t* __restrict__ Wt, int shift_from, int shift, int part, int nparts, float* tl) {
    const int tid = threadIdx.x;
    const int nKt = K / 64, nNt = (N + 63) / 64, ntile = nKt * nNt;
    for (int t = part; t < ntile; t += nparts) {
        const int nt = t / nKt, kt = t - nt * nKt, k0 = kt * 64, n0 = nt * 64;
#pragma unroll
        for (int e = 0; e < 8; ++e) { const int idx = tid + e * 512, i = idx >> 6, j = idx & 63, n = n0 + j;
            tl[i * 65 + j] = (n < N) ? W[(size_t)(k0 + i) * N + n] : 0.f; }
        __syncthreads();
#pragma unroll
        for (int e = 0; e < 4; ++e) { const int p = tid + e * 512, j = p >> 5, i = (p & 31) * 2, n = n0 + j;
            if (n < N) { const int dr = (n >= shift_from) ? n + shift : n;
                *(unsigned*)(Wt + (size_t)dr * K + k0 + i) = cvt_pk_bf16(tl[i * 65 + j], tl[(i + 1) * 65 + j]); } }
        __syncthreads();
    }
}

struct EpiAda { static constexpr bool PERM = false, AFTER_DRAIN = false; float* ada; const float* b_ada;
    __device__ __forceinline__ void operator()(const f32x4 (&acc)[2][2][4][2], const Unit& u, int wr, int wc, int fr, int fq) const {
        const int row0 = u.pm * BM + wr * 64 + fr, col0 = u.pn * BM + wc * 32 + 4 * fq;
#pragma unroll
        for (int ai = 0; ai < 2; ++ai)
#pragma unroll
            for (int m = 0; m < 4; ++m) { const int row = row0 + ai * HALF + m * 16;
                if (row < 132) {
#pragma unroll
                    for (int bj = 0; bj < 2; ++bj)
#pragma unroll
                        for (int n = 0; n < 2; ++n) { const int col = col0 + bj * HALF + n * 16;
                            *(f32x4*)(ada + (size_t)row * NADA + col) = acc[ai][bj][m][n] + *(const f32x4*)(b_ada + col); } } }
    }
};
struct EpiBf16P { static constexpr bool PERM = true, AFTER_DRAIN = false; bf16_t* O; int ldc;
    __device__ __forceinline__ void operator()(const f32x4 (&acc)[2][2][4][2], const Unit& u, int wr, int wc, int fr, int fq) const {
        const int row0 = u.pm * BM + wr * 64 + fr, col0 = u.pn * BM + wc * 32 + 8 * fq;
#pragma unroll
        for (int ai = 0; ai < 2; ++ai)
#pragma unroll
            for (int m = 0; m < 4; ++m) { bf16_t* rowp = O + (size_t)(row0 + ai * HALF + m * 16) * ldc + col0;
#pragma unroll
                for (int bj = 0; bj < 2; ++bj) { const f32x4 v0 = acc[ai][bj][m][0], v1 = acc[ai][bj][m][1];
                    u32x4 w; w.x = cvt_pk_bf16(v0[0], v0[1]); w.y = cvt_pk_bf16(v0[2], v0[3]); w.z = cvt_pk_bf16(v1[0], v1[1]); w.w = cvt_pk_bf16(v1[2], v1[3]);
                    *(u32x4*)(rowp + bj * HALF) = w; } }
    }
};
struct EpiUp { static constexpr bool PERM = true, AFTER_DRAIN = false; bf16_t* O; float* out;
    __device__ __forceinline__ void operator()(const f32x4 (&acc)[2][2][4][2], const Unit& u, int wr, int wc, int fr, int fq) const {
        const int row0 = u.pm * BM + wr * 64 + fr, col0 = u.pn * BM + wc * 32 + 8 * fq;
#pragma unroll
        for (int ai = 0; ai < 2; ++ai)
#pragma unroll
            for (int m = 0; m < 4; ++m) { const int row = row0 + ai * HALF + m * 16; bf16_t* rowp = O + (size_t)row * F2 + col0;
                float* cdst = nullptr;
                if (row < MPR) { const int t = row & (SEQ - 1); if (t >= SEQ - 2) cdst = out + O_CONVP + ((size_t)(row >> 11) * 2 + (t - (SEQ - 2))) * F2; }
                else if (row < MTOK) cdst = out + O_CONVS + ((size_t)(row - MPR) * 2 + 1) * F2;
#pragma unroll
                for (int bj = 0; bj < 2; ++bj) { const f32x4 v0 = acc[ai][bj][m][0], v1 = acc[ai][bj][m][1];
                    u32x4 w; w.x = cvt_pk_bf16(v0[0], v0[1]); w.y = cvt_pk_bf16(v0[2], v0[3]); w.z = cvt_pk_bf16(v1[0], v1[1]); w.w = cvt_pk_bf16(v1[2], v1[3]);
                    *(u32x4*)(rowp + bj * HALF) = w;
                    if (cdst) { *(f32x4*)(cdst + col0 + bj * HALF) = v0; *(f32x4*)(cdst + col0 + bj * HALF + 4) = v1; } } }
    }
};
struct EpiLora { static constexpr bool PERM = false, AFTER_DRAIN = false; float* dec; float* aa; bf16_t* gg; const float* w0; const float* a0;
    __device__ __forceinline__ void operator()(const f32x4 (&acc)[2][2][4][2], const Unit& u, int wr, int wc, int fr, int fq) const {
        const int kind = u.pn >> 2;
        const int row0 = u.pm * BM + wr * 64 + fr, col0 = (u.pn & 3) * BM + wc * 32 + 4 * fq;
#pragma unroll
        for (int ai = 0; ai < 2; ++ai)
#pragma unroll
            for (int m = 0; m < 4; ++m) { const size_t ro = (size_t)(row0 + ai * HALF + m * 16) * RW;
#pragma unroll
                for (int bj = 0; bj < 2; ++bj)
#pragma unroll
                    for (int n = 0; n < 2; ++n) { const int col = col0 + bj * HALF + n * 16; const f32x4 v = acc[ai][bj][m][n];
                        if (kind == 0) { const f32x4 b = *(const f32x4*)(w0 + col); f32x4 o;
#pragma unroll
                            for (int j = 0; j < 4; ++j) { const float x = b[j] + v[j], y = -x; const float sp = fmaxf(y, 0.f) + __logf(1.0f + __expf(-fabsf(y))); const float w = -sp - 0.5f; o[j] = __expf(-__expf(w)); }
                            *(f32x4*)(dec + ro + col) = o; }
                        else if (kind == 1) { const f32x4 b = *(const f32x4*)(a0 + col); f32x4 o;
#pragma unroll
                            for (int j = 0; j < 4; ++j) o[j] = sigmoidf_(b[j] + v[j]);
                            *(f32x4*)(aa + ro + col) = o; }
                        else { u32x2 w; w.x = cvt_pk_bf16(v[0], v[1]); w.y = cvt_pk_bf16(v[2], v[3]); *(u32x2*)(gg + ro + col) = w; } } }
    }
};
template <int WHICH> struct EpiBranch { static constexpr bool PERM = false, AFTER_DRAIN = false; const bf16_t* proj; float* tmp; bf16_t* merged;
    __device__ __forceinline__ void operator()(const f32x4 (&acc)[2][2][4][2], const Unit& u, int wr, int wc, int fr, int fq) const {
        const int row0 = u.pm * BM + wr * 64 + fr, col0 = u.pn * BM + wc * 32 + 4 * fq;
#pragma unroll
        for (int ai = 0; ai < 2; ++ai)
#pragma unroll
            for (int m = 0; m < 4; ++m) { const int row = row0 + ai * HALF + m * 16; const bool real = row < MTOK;
#pragma unroll
                for (int bj = 0; bj < 2; ++bj)
#pragma unroll
                    for (int n = 0; n < 2; ++n) { const int col = col0 + bj * HALF + n * 16; const f32x4 v = acc[ai][bj][m][n];
                        if (WHICH == 0) { if (real) { const u32x2 gw = *(const u32x2*)(proj + (size_t)row * NINP + C_GA + col);
                                f32x4 o; o[0] = sigmoidf_(lo_bf(gw.x)) * v[0]; o[1] = sigmoidf_(hi_bf(gw.x)) * v[1]; o[2] = sigmoidf_(lo_bf(gw.y)) * v[2]; o[3] = sigmoidf_(hi_bf(gw.y)) * v[3];
                                *(f32x4*)(tmp + (size_t)row * D + col) = o; } }
                        else { u32x2 w; w.x = 0u; w.y = 0u;
                            if (real) { const u32x2 gw = *(const u32x2*)(proj + (size_t)row * NINP + C_GB + col); const f32x4 t = *(const f32x4*)(tmp + (size_t)row * D + col);
                                w.x = cvt_pk_bf16(t[0] + sigmoidf_(lo_bf(gw.x)) * v[0], t[1] + sigmoidf_(hi_bf(gw.x)) * v[1]);
                                w.y = cvt_pk_bf16(t[2] + sigmoidf_(lo_bf(gw.y)) * v[2], t[3] + sigmoidf_(hi_bf(gw.y)) * v[3]); }
                            *(u32x2*)(merged + (size_t)row * D + col) = w; } } }
    }
};
template <int WHICH> struct EpiRes { static constexpr bool PERM = false, AFTER_DRAIN = false; const float* xp; const float* xs; const float* ada; float* dst;
    __device__ __forceinline__ void operator()(const f32x4 (&acc)[2][2][4][2], const Unit& u, int wr, int wc, int fr, int fq) const {
        const int row0 = u.pm * BM + wr * 64 + fr, col0 = u.pn * BM + wc * 32 + 4 * fq;
#pragma unroll
        for (int ai = 0; ai < 2; ++ai)
#pragma unroll
            for (int m = 0; m < 4; ++m) { const int row = row0 + ai * HALF + m * 16;
                if (row < MTOK) { const float* g = ada + (size_t)ada_row(row) * NADA + (WHICH == 0 ? 2 * D : 5 * D);
                    const float* base = (WHICH == 0) ? (row < MPR ? xp + (size_t)row * D : xs + (size_t)(row - MPR) * D) : dst + (size_t)row * D;
#pragma unroll
                    for (int bj = 0; bj < 2; ++bj)
#pragma unroll
                        for (int n = 0; n < 2; ++n) { const int col = col0 + bj * HALF + n * 16;
                            const f32x4 bv = *(const f32x4*)(base + col), gv = *(const f32x4*)(g + col);
                            *(f32x4*)(dst + (size_t)row * D + col) = bv * ALPHA + gv * acc[ai][bj][m][n]; } } }
    }
};

__device__ __forceinline__ bf16x8 ldfrag(const bf16_t* base, int row, int stride, int k) { return *(const bf16x8*)(base + row * stride + k); }
#define MFMA16(x, y, c) __builtin_amdgcn_mfma_f32_16x16x32_bf16((x), (y), (c), 0, 0, 0)

template <int CTRL> __device__ __forceinline__ float dpp_f(float x) { return __int_as_float(__builtin_amdgcn_update_dpp(0, __float_as_int(x), CTRL, 0xF, 0xF, true)); }
__device__ __forceinline__ float row16_sum(float x) { x += dpp_f<0xB1>(x); x += dpp_f<0x4E>(x); x += dpp_f<0x141>(x); x += dpp_f<0x140>(x); return x; }

static __device__ __forceinline__ void ret_prompt_item(const Params& P, int b, int h, unsigned char* smem) {
    const int tid = threadIdx.x, lane = tid & 63, wave = tid >> 6, fr = lane & 15, fq = lane >> 4;
    bf16_t* Qs = (bf16_t*)smem;
    bf16_t* Ks = Qs + 64 * 136;
    bf16_t* Kdt = Ks + 64 * 136;
    bf16_t* Vt = Kdt + 128 * 72;
    bf16_t* Ps = Vt + 128 * 72;
    bf16_t* St = Ps + 64 * 72;
    float* gpow = (float*)(St + 128 * 136);
    const bf16_t* proj = (const bf16_t*)(P.ws + WS_RA);
    const float* cosT = (const float*)(P.ws + WS_ROPE); const float* sinT = cosT + 2049 * 64;
    float* oret = P.out;
    const float log_g = log1pf(-exp2f(-5.0f - (float)h));
    if (tid < 80) gpow[tid] = expf(log_g * (float)tid);
    for (int i = tid; i < 128 * 136 / 2; i += 512) ((unsigned*)St)[i] = 0u;
    f32x4 S[8];
#pragma unroll
    for (int i = 0; i < 8; ++i) S[i] = (f32x4){0.f, 0.f, 0.f, 0.f};
    __syncthreads();
    const int j = tid >> 3, dg = tid & 7;
    for (int c = 0; c < SEQ / 64; ++c) {
        {
            const int pos = c * 64 + j; const size_t row = (size_t)b * SEQ + pos;
            const bf16_t* pr = proj + row * NINP + h * 128;
            const u32x4 q1 = *(const u32x4*)(pr + C_Q + dg * 8), q2 = *(const u32x4*)(pr + C_Q + 64 + dg * 8);
            const u32x4 k1 = *(const u32x4*)(pr + C_K + dg * 8), k2 = *(const u32x4*)(pr + C_K + 64 + dg * 8);
            const u32x4 v1 = *(const u32x4*)(pr + C_V + dg * 16), v2 = *(const u32x4*)(pr + C_V + dg * 16 + 8);
            const f32x4 c0 = *(const f32x4*)(cosT + pos * 64 + dg * 8), c1 = *(const f32x4*)(cosT + pos * 64 + dg * 8 + 4);
            const f32x4 s0 = *(const f32x4*)(sinT + pos * 64 + dg * 8), s1 = *(const f32x4*)(sinT + pos * 64 + dg * 8 + 4);
            float cs[8] = {c0[0], c0[1], c0[2], c0[3], c1[0], c1[1], c1[2], c1[3]}, sn[8] = {s0[0], s0[1], s0[2], s0[3], s1[0], s1[1], s1[2], s1[3]};
            const unsigned qa[4] = {q1.x, q1.y, q1.z, q1.w}, qb[4] = {q2.x, q2.y, q2.z, q2.w}, ka[4] = {k1.x, k1.y, k1.z, k1.w}, kb[4] = {k2.x, k2.y, k2.z, k2.w};
            float qo1[8], qo2[8], ko1[8], ko2[8];
#pragma unroll
            for (int e = 0; e < 4; ++e) {
#pragma unroll
                for (int hh = 0; hh < 2; ++hh) { const int i = e * 2 + hh;
                    const float a1 = hh ? hi_bf(qa[e]) : lo_bf(qa[e]), a2 = hh ? hi_bf(qb[e]) : lo_bf(qb[e]);
                    const float b1 = hh ? hi_bf(ka[e]) : lo_bf(ka[e]), b2 = hh ? hi_bf(kb[e]) : lo_bf(kb[e]);
                    qo1[i] = a1 * cs[i] - a2 * sn[i]; qo2[i] = a1 * sn[i] + a2 * cs[i];
                    ko1[i] = (b1 * cs[i] - b2 * sn[i]) * 0.08838834764831845f; ko2[i] = (b1 * sn[i] + b2 * cs[i]) * 0.08838834764831845f; } }
            u32x4 w;
            w.x = cvt_pk_bf16(qo1[0], qo1[1]); w.y = cvt_pk_bf16(qo1[2], qo1[3]); w.z = cvt_pk_bf16(qo1[4], qo1[5]); w.w = cvt_pk_bf16(qo1[6], qo1[7]); *(u32x4*)(Qs + j * 136 + dg * 8) = w;
            w.x = cvt_pk_bf16(qo2[0], qo2[1]); w.y = cvt_pk_bf16(qo2[2], qo2[3]); w.z = cvt_pk_bf16(qo2[4], qo2[5]); w.w = cvt_pk_bf16(qo2[6], qo2[7]); *(u32x4*)(Qs + j * 136 + 64 + dg * 8) = w;
            w.x = cvt_pk_bf16(ko1[0], ko1[1]); w.y = cvt_pk_bf16(ko1[2], ko1[3]); w.z = cvt_pk_bf16(ko1[4], ko1[5]); w.w = cvt_pk_bf16(ko1[6], ko1[7]); *(u32x4*)(Ks + j * 136 + dg * 8) = w;
            w.x = cvt_pk_bf16(ko2[0], ko2[1]); w.y = cvt_pk_bf16(ko2[2], ko2[3]); w.z = cvt_pk_bf16(ko2[4], ko2[5]); w.w = cvt_pk_bf16(ko2[6], ko2[7]); *(u32x4*)(Ks + j * 136 + 64 + dg * 8) = w;
            const float kd = gpow[63 - j];
#pragma unroll
            for (int i = 0; i < 8; ++i) { Kdt[(dg * 8 + i) * 72 + j] = f2bf(ko1[i] * kd); Kdt[(64 + dg * 8 + i) * 72 + j] = f2bf(ko2[i] * kd); }
            const unsigned va[8] = {v1.x, v1.y, v1.z, v1.w, v2.x, v2.y, v2.z, v2.w};
#pragma unroll
            for (int e = 0; e < 8; ++e) { Vt[(dg * 16 + 2 * e) * 72 + j] = (bf16_t)(va[e] & 0xffffu); Vt[(dg * 16 + 2 * e + 1) * 72 + j] = (bf16_t)(va[e] >> 16); }
        }
        __syncthreads();
        f32x4 O[4];
#pragma unroll
        for (int it = 0; it < 4; ++it) O[it] = (f32x4){0.f, 0.f, 0.f, 0.f};
#pragma unroll
        for (int ks = 0; ks < 4; ++ks) { const bf16x8 yf = ldfrag(St, wave * 16 + fr, 136, ks * 32 + fq * 8);
#pragma unroll
            for (int it = 0; it < 4; ++it) O[it] = MFMA16(ldfrag(Qs, it * 16 + fr, 136, ks * 32 + fq * 8), yf, O[it]); }
#pragma unroll
        for (int it = 0; it < 4; ++it)
#pragma unroll
            for (int jj = 0; jj < 4; ++jj) O[it][jj] *= gpow[it * 16 + fq * 4 + jj + 1];
        { const int it = wave >> 1;
#pragma unroll
            for (int j2 = 0; j2 < 2; ++j2) { const int jt = (wave & 1) * 2 + j2; f32x4 a = (f32x4){0.f, 0.f, 0.f, 0.f};
#pragma unroll
                for (int ks = 0; ks < 4; ++ks) a = MFMA16(ldfrag(Qs, it * 16 + fr, 136, ks * 32 + fq * 8), ldfrag(Ks, jt * 16 + fr, 136, ks * 32 + fq * 8), a);
#pragma unroll
                for (int jj = 0; jj < 4; ++jj) { const int i = it * 16 + fq * 4 + jj, jc = jt * 16 + fr; const int dd = i - jc;
                    const float pv = dd >= 0 ? a[jj] * gpow[dd >= 0 ? dd : 0] : 0.f; Ps[i * 72 + jc] = f2bf(pv); } } }
        __syncthreads();
#pragma unroll
        for (int ks = 0; ks < 2; ++ks) { const bf16x8 yf = ldfrag(Vt, wave * 16 + fr, 72, ks * 32 + fq * 8);
#pragma unroll
            for (int it = 0; it < 4; ++it) O[it] = MFMA16(ldfrag(Ps, it * 16 + fr, 72, ks * 32 + fq * 8), yf, O[it]); }
#pragma unroll
        for (int it = 0; it < 4; ++it)
#pragma unroll
            for (int jj = 0; jj < 4; ++jj) { const int i = it * 16 + fq * 4 + jj; oret[((size_t)b * SEQ + c * 64 + i) * RW + h * 128 + wave * 16 + fr] = O[it][jj]; }
        { const float bd = gpow[64];
#pragma unroll
            for (int dt = 0; dt < 8; ++dt) S[dt] *= bd;
#pragma unroll
            for (int ks = 0; ks < 2; ++ks) { const bf16x8 yf = ldfrag(Vt, wave * 16 + fr, 72, ks * 32 + fq * 8);
#pragma unroll
                for (int dt = 0; dt < 8; ++dt) S[dt] = MFMA16(ldfrag(Kdt, dt * 16 + fr, 72, ks * 32 + fq * 8), yf, S[dt]); } }
        __syncthreads();
#pragma unroll
        for (int dt = 0; dt < 8; ++dt) { u32x2 w; w.x = cvt_pk_bf16(S[dt][0], S[dt][1]); w.y = cvt_pk_bf16(S[dt][2], S[dt][3]); *(u32x2*)(St + (wave * 16 + fr) * 136 + dt * 16 + fq * 4) = w; }
    }
    float* so = P.out + O_RETP + (size_t)(b * 8 + h) * 128 * 128;
#pragma unroll
    for (int dt = 0; dt < 8; ++dt)
#pragma unroll
        for (int jj = 0; jj < 4; ++jj) so[(dt * 16 + fq * 4 + jj) * 128 + wave * 16 + fr] = S[dt][jj];
    __syncthreads();
}

static __device__ __forceinline__ void ret_sample_pair(const Params& P, int pair, unsigned char* smem) {
    const int tid = threadIdx.x, lane = tid & 63;
    float* qs = (float*)smem; float* ks = qs + 128; float* red = ks + 128;
    const int i = pair >> 3, h = pair & 7; const size_t row = (size_t)MPR + i;
    const bf16_t* pr = (const bf16_t*)(P.ws + WS_RA) + row * NINP + h * 128;
    const float* cosT = (const float*)(P.ws + WS_ROPE) + 2048 * 64; const float* sinT = cosT + 2049 * 64;
    if (tid < 64) { const float cc = cosT[tid], ss = sinT[tid];
        const float a1 = bf2f(pr[C_Q + tid]), a2 = bf2f(pr[C_Q + 64 + tid]), b1 = bf2f(pr[C_K + tid]), b2 = bf2f(pr[C_K + 64 + tid]);
        qs[tid] = a1 * cc - a2 * ss; qs[64 + tid] = a1 * ss + a2 * cc;
        ks[tid] = (b1 * cc - b2 * ss) * 0.08838834764831845f; ks[64 + tid] = (b1 * ss + b2 * cc) * 0.08838834764831845f; }
    __syncthreads();
    const float qk = wave_sum(qs[lane] * ks[lane] + qs[64 + lane] * ks[64 + lane]);
    const int dv = tid & 127, g = tid >> 7;
    const float vv = bf2f(pr[C_V + dv]);
    const float gam = 1.0f - exp2f(-5.0f - (float)h);
    const float* S0 = P.in[I_SRET] + (size_t)pair * 128 * 128; float* So = P.out + O_RETS + (size_t)pair * 128 * 128;
    float acc = 0.f;
#pragma unroll 8
    for (int dk = g * 32; dk < g * 32 + 32; ++dk) { const float s = S0[dk * 128 + dv]; acc += qs[dk] * s; So[dk * 128 + dv] = gam * s + ks[dk] * vv; }
    red[g * 128 + dv] = acc;
    __syncthreads();
    if (tid < 128) P.out[row * RW + h * 128 + dv] = qk * vv + gam * (red[dv] + red[128 + dv] + red[256 + dv] + red[384 + dv]);
    __syncthreads();
}

static __device__ __forceinline__ void rwkv_prompt_item(const Params& P, int item, unsigned char* smem) {
    const int tid = threadIdx.x, lane = tid & 63, wave = tid >> 6;
    const int bh = item >> 2, qt = item & 3, b = bh >> 4, h = bh & 15;
    float* KK = (float*)smem; float* WW = KK + 2048; float* BB = WW + 2048; float* KX = BB + 2048; float* RR = KX + 2048; float* VV = RR + 2048; float* OO = VV + 2048;
    const bf16_t* proj = (const bf16_t*)(P.ws + WS_RA);
    const float* decA = (const float*)(P.ws + WS_RB); const float* aaA = decA + (size_t)MP * RW;
    float* oraw = (float*)(P.ws + WS_RC); float* bonus = (float*)(P.ws + WS_BONUS);
    const int col = h * 64 + lane;
    const float mu_r = P.in[I_MU][col], mu_k = P.in[I_MU][RW + col], mu_v = P.in[I_MU][2 * RW + col];
    const float kk_c = P.in[I_KK][col], ka_c = P.in[I_KA][col], rk_c = P.in[I_RK][col];
    float zr[5], zk[5], zv[5], av[4], dv_[4];
    const size_t rowb = (size_t)b * SEQ;
    auto dummy = 0; (void)dummy;
#define RWKV_LOAD(c) do { const int t0 = (c) * 32 + wave * 4; \
        _Pragma("unroll") for (int e = 0; e < 5; ++e) { const int t = t0 + e - 1; \
            if (t >= 0) { const bf16_t* pz = proj + (rowb + t) * NINP + col; zr[e] = bf2f(pz[0]); zk[e] = bf2f(pz[RW]); zv[e] = bf2f(pz[2 * RW]); } else { zr[e] = 0.f; zk[e] = 0.f; zv[e] = 0.f; } } \
        _Pragma("unroll") for (int e = 0; e < 4; ++e) { av[e] = aaA[(rowb + t0 + e) * RW + col]; dv_[e] = decA[(rowb + t0 + e) * RW + col]; } } while (0)
    RWKV_LOAD(0);
    const int rr = lane >> 4, s = lane & 15, vrow = qt * 16 + (wave & 3) * 4 + rr;
    float S0 = 0.f, S1 = 0.f, S2 = 0.f, S3 = 0.f;
    for (int c = 0; c < SEQ / 32; ++c) {
#pragma unroll
        for (int e = 0; e < 4; ++e) { const int tt = wave * 4 + e;
            const float r = zr[e + 1] + mu_r * (zr[e] - zr[e + 1]), k = zk[e + 1] + mu_k * (zk[e] - zk[e + 1]), v = zv[e + 1] + mu_v * (zv[e] - zv[e + 1]);
            const float kkv = k * kk_c; const float nrm = sqrtf(wave_sum(kkv * kkv)); const float kkn = kkv / fmaxf(nrm, 1e-12f);
            const float a = av[e]; const float kx = k * (1.0f + (a - 1.0f) * ka_c);
            const float bo = wave_sum(r * kx * rk_c);
            KK[tt * 64 + lane] = kkn; WW[tt * 64 + lane] = dv_[e]; BB[tt * 64 + lane] = kkn * a; KX[tt * 64 + lane] = kx; RR[tt * 64 + lane] = r; VV[tt * 64 + lane] = v;
            if (qt == 0 && lane == 0) bonus[(rowb + c * 32 + tt) * 16 + h] = bo; }
        __syncthreads();
        if (c + 1 < SEQ / 32) RWKV_LOAD(c + 1);
        if (wave < 4) {
            float ok0 = 0.f, ok1 = 0.f;
#pragma unroll
            for (int tt = 0; tt < 32; ++tt) {
                const f32x4 kk4 = *(const f32x4*)(KK + tt * 64 + s * 4), w4 = *(const f32x4*)(WW + tt * 64 + s * 4), b4 = *(const f32x4*)(BB + tt * 64 + s * 4);
                const f32x4 kx4 = *(const f32x4*)(KX + tt * 64 + s * 4), r4 = *(const f32x4*)(RR + tt * 64 + s * 4); const float vv = VV[tt * 64 + vrow];
                const float sa = -row16_sum(S0 * kk4[0] + S1 * kk4[1] + S2 * kk4[2] + S3 * kk4[3]);
                S0 = S0 * w4[0] + (sa * b4[0] + vv * kx4[0]); S1 = S1 * w4[1] + (sa * b4[1] + vv * kx4[1]); S2 = S2 * w4[2] + (sa * b4[2] + vv * kx4[2]); S3 = S3 * w4[3] + (sa * b4[3] + vv * kx4[3]);
                const float os = row16_sum(S0 * r4[0] + S1 * r4[1] + S2 * r4[2] + S3 * r4[3]);
                if (tt < 16) { if (s == tt) ok0 = os; } else { if (s == tt - 16) ok1 = os; }
            }
            OO[s * 16 + (wave * 4 + rr)] = ok0; OO[(16 + s) * 16 + (wave * 4 + rr)] = ok1;
        }
        __syncthreads();
        { const int tt = tid >> 4, i = tid & 15; oraw[(rowb + c * 32 + tt) * RW + h * 64 + qt * 16 + i] = OO[tid]; }
    }
#undef RWKV_LOAD
    if (wave < 4) { f32x4 o = {S0, S1, S2, S3}; *(f32x4*)(P.out + O_WKVP + ((size_t)(b * 16 + h) * 64 + vrow) * 64 + s * 4) = o; }
    __syncthreads();
}

static __device__ __forceinline__ void rwkv_sample_pair(const Params& P, int pair) {
    const int lane = threadIdx.x & 63; const int i = pair >> 4, h = pair & 15; const size_t row = (size_t)MPR + i; const int col = h * 64 + lane;
    const bf16_t* pz = (const bf16_t*)(P.ws + WS_RA) + row * NINP + col;
    const float* sp = P.in[I_SSHIFT] + (size_t)i * PRW + col;
    const float zr = bf2f(pz[0]), zk = bf2f(pz[RW]), zv = bf2f(pz[2 * RW]);
    const float r = zr + P.in[I_MU][col] * (sp[0] - zr), k = zk + P.in[I_MU][RW + col] * (sp[RW] - zk), v = zv + P.in[I_MU][2 * RW + col] * (sp[2 * RW] - zv);
    const float* decA = (const float*)(P.ws + WS_RB); const float* aaA = decA + (size_t)MP * RW;
    const float a = aaA[row * RW + col], dec = decA[row * RW + col];
    const float kkv = k * P.in[I_KK][col]; const float nrm = sqrtf(wave_sum(kkv * kkv)); const float kkn = kkv / fmaxf(nrm, 1e-12f);
    const float kx = k * (1.0f + (a - 1.0f) * P.in[I_KA][col]); const float bb = kkn * a;
    const float bo = wave_sum(r * kx * P.in[I_RK][col]);
    if (lane == 0) ((float*)(P.ws + WS_BONUS))[row * 16 + h] = bo;
    const float* S0 = P.in[I_SWKV] + (size_t)pair * 4096; float* So = P.out + O_WKVS + (size_t)pair * 4096;
    float omine = 0.f;
#pragma unroll 8
    for (int vr = 0; vr < 64; ++vr) { const float sv = S0[vr * 64 + lane]; const float sa = -wave_sum(sv * kkn); const float vv = __shfl(v, vr);
        const float sn = sv * dec + sa * bb + vv * kx; So[vr * 64 + lane] = sn; const float o = wave_sum(sn * r); if (lane == vr) omine = o; }
    ((float*)(P.ws + WS_RC))[row * RW + col] = omine;
}

static __device__ __forceinline__ void phase_misc0(const Params& P) {
    const size_t gtid = (size_t)blockIdx.x * 512 + threadIdx.x, gsz = (size_t)gridDim.x * 512;
    bf16_t* aada = (bf16_t*)(P.ws + WS_AADA);
    for (size_t i = gtid; i < (size_t)256 * D; i += gsz) { const int r = (int)(i / D), c = (int)(i % D);
        const float v = r < NB ? P.in[I_CP][r * D + c] : (r < NB + NS ? P.in[I_CS][(r - NB) * D + c] : 0.f); aada[i] = f2bf(v); }
    float* cosT = (float*)(P.ws + WS_ROPE); float* sinT = cosT + 2049 * 64;
    for (size_t i = gtid; i < (size_t)2049 * 64; i += gsz) { const int pi = (int)(i >> 6), jx = (int)(i & 63);
        const double pos = pi == 2048 ? 16384.0 : (double)pi;
        const float inv = (float)exp(-((double)jx / 64.0) * 9.210340371976184);
        const double ang = pos * (double)inv;
        const double n = rint(ang * 0.15915494309189535); const double rr = ang - n * 6.283185307179586;
        const double r2 = rr * rr; double ts = rr, tc = 1.0, sv = rr, cv = 1.0;
#pragma unroll 1
        for (int k = 1; k <= 13; ++k) { tc *= -r2 / (double)((2 * k - 1) * (2 * k)); ts *= -r2 / (double)((2 * k) * (2 * k + 1)); cv += tc; sv += ts; }
        cosT[i] = (float)cv; sinT[i] = (float)sv; }
}
static __device__ __forceinline__ void phase_misc1(const Params& P, size_t gtid, size_t gsz) {
    unsigned* z = (unsigned*)((bf16_t*)(P.ws + WS_WIN) + (size_t)PRW * D);
    for (size_t i = gtid; i < (size_t)(C_Q - PRW) * D / 2; i += gsz) z[i] = 0u;
    bf16_t* bl = (bf16_t*)(P.ws + WS_WLORA);
    for (size_t i = gtid; i < (size_t)NL * KL; i += gsz) { const int n = (int)(i / KL), k = (int)(i % KL); float v = 0.f;
        if (n < 1024) { if (k < 64) v = P.in[I_WDEC][k * RW + n]; }
        else if (n < 2048) { if (k >= 64 && k < 128) v = P.in[I_WAAA][(k - 64) * RW + (n - 1024)]; }
        else { if (k >= 128 && k < 288) v = P.in[I_WGATE][(k - 128) * RW + (n - 2048)]; }
        bl[i] = f2bf(v); }
}
static __device__ __forceinline__ void phase_modulate(const Params& P) {
    const float* ada = (const float*)(P.ws + WS_ADA); bf16_t* u = (bf16_t*)(P.ws + WS_RC);
    for (size_t i = (size_t)blockIdx.x * 512 + threadIdx.x; i < (size_t)MP * (D / 8); i += (size_t)gridDim.x * 512) {
        const int row = (int)(i >> 8), c = (int)(i & 255) * 8; u32x4 w = {0u, 0u, 0u, 0u};
        if (row < MTOK) { const float* x = row < MPR ? P.in[I_XP] + (size_t)row * D : P.in[I_XS] + (size_t)(row - MPR) * D; const float* ar = ada + (size_t)ada_row(row) * NADA;
            const f32x4 x0 = *(const f32x4*)(x + c), x1 = *(const f32x4*)(x + c + 4), h0 = *(const f32x4*)(ar + c), h1 = *(const f32x4*)(ar + c + 4), s0 = *(const f32x4*)(ar + D + c), s1 = *(const f32x4*)(ar + D + c + 4);
            const f32x4 a = x0 * (s0 + 1.0f) + h0, b = x1 * (s1 + 1.0f) + h1;
            w.x = cvt_pk_bf16(a[0], a[1]); w.y = cvt_pk_bf16(a[2], a[3]); w.z = cvt_pk_bf16(b[0], b[1]); w.w = cvt_pk_bf16(b[2], b[3]); }
        *(u32x4*)(u + (size_t)row * D + c) = w; }
}
static __device__ __forceinline__ void phase_lora_in(const Params& P) {
    const bf16_t* proj = (const bf16_t*)(P.ws + WS_RA); bf16_t* al = (bf16_t*)(P.ws + WS_ALORA);
    const size_t gtid = (size_t)blockIdx.x * 512 + threadIdx.x, gsz = (size_t)gridDim.x * 512;
    for (size_t i = gtid; i < (size_t)MP * KL; i += gsz) { const int row = (int)(i / KL), k = (int)(i % KL); float o = 0.f;
        if (row < MTOK && k < 288) { const int c = 3072 + k; const float z = bf2f(proj[(size_t)row * NINP + c]); float prev;
            if (row < MPR) prev = (row & (SEQ - 1)) == 0 ? 0.f : bf2f(proj[(size_t)(row - 1) * NINP + c]); else prev = P.in[I_SSHIFT][(size_t)(row - MPR) * PRW + c];
            const float zs = z + P.in[I_MU][c] * (prev - z);
            o = k < 64 ? tanhf(zs) : (k < 128 ? zs : sigmoidf_(zs)); }
        al[i] = f2bf(o); }
    for (size_t i = gtid; i < (size_t)(NB + NS) * PRW; i += gsz) { const int r = (int)(i / PRW), c = (int)(i % PRW);
        const size_t row = r < NB ? (size_t)r * SEQ + SEQ - 1 : (size_t)MPR + (r - NB);
        const float v = bf2f(proj[row * NINP + c]);
        if (r < NB) P.out[O_SHIFTP + (size_t)r * PRW + c] = v; else P.out[O_SHIFTS + (size_t)(r - NB) * PRW + c] = v; }
}
static __device__ __forceinline__ void phase_post(const Params& P) {
    const int lane = threadIdx.x & 63, wave = threadIdx.x >> 6;
    const bf16_t* proj = (const bf16_t*)(P.ws + WS_RA); const float* oraw = (const float*)(P.ws + WS_RC); const float* oret = P.out;
    const float* bonus = (const float*)(P.ws + WS_BONUS); const bf16_t* gg = (const bf16_t*)(P.ws + WS_RB + (size_t)2 * MP * RW * 4);
    bf16_t* ya = (bf16_t*)(P.ws + WS_RD); bf16_t* yb = ya + (size_t)MP * RW;
    for (int row = blockIdx.x; row < MP; row += gridDim.x) {
        if (row >= MTOK) { for (int c = threadIdx.x; c < RW; c += 512) { ya[(size_t)row * RW + c] = 0; yb[(size_t)row * RW + c] = 0; } continue; }
#pragma unroll
        for (int hh = 0; hh < 2; ++hh) { const int h = wave * 2 + hh, col = h * 64 + lane;
            const float o = oraw[(size_t)row * RW + col]; const float mean = wave_sum(o) * (1.0f / 64.0f); const float d = o - mean; const float var = wave_sum(d * d) * (1.0f / 64.0f);
            float y = d * rsqrtf(var + 64e-5f) * P.in[I_LNXW][col] + P.in[I_LNXB][col];
            const float zv = bf2f(proj[(size_t)row * NINP + 2 * RW + col]); float prev;
            if (row < MPR) prev = (row & (SEQ - 1)) == 0 ? 0.f : bf2f(proj[(size_t)(row - 1) * NINP + 2 * RW + col]); else prev = P.in[I_SSHIFT][(size_t)(row - MPR) * PRW + 2 * RW + col];
            const float v = zv + P.in[I_MU][2 * RW + col] * (prev - zv);
            y = (y + bonus[(size_t)row * 16 + h] * v) * bf2f(gg[(size_t)row * RW + col]);
            ya[(size_t)row * RW + col] = f2bf(y); }
        { const int h = wave, c0 = h * 128 + lane, c1 = c0 + 64;
            const float o0 = oret[(size_t)row * RW + c0], o1 = oret[(size_t)row * RW + c1]; const float mean = wave_sum(o0 + o1) * (1.0f / 128.0f);
            const float d0 = o0 - mean, d1 = o1 - mean; const float var = wave_sum(d0 * d0 + d1 * d1) * (1.0f / 128.0f); const float rs = rsqrtf(var + 1e-5f);
            const float g0 = bf2f(proj[(size_t)row * NINP + C_RG + c0]), g1 = bf2f(proj[(size_t)row * NINP + C_RG + c1]);
            const float y0 = (d0 * rs * P.in[I_RGNW][c0] + P.in[I_RGNB][c0]) * (g0 * sigmoidf_(g0)), y1 = (d1 * rs * P.in[I_RGNW][c1] + P.in[I_RGNB][c1]) * (g1 * sigmoidf_(g1));
            yb[(size_t)row * RW + c0] = f2bf(y0); yb[(size_t)row * RW + c1] = f2bf(y1); }
    }
}
template <int WHICH> static __device__ __forceinline__ void phase_ln(const Params& P) {
    const int lane = threadIdx.x & 63, wave = threadIdx.x >> 6;
    const float* lw = P.in[WHICH == 0 ? I_LN1W : I_LN2W]; const float* lb = P.in[WHICH == 0 ? I_LN1B : I_LN2B];
    const float* ada = (const float*)(P.ws + WS_ADA); bf16_t* u2 = (bf16_t*)(P.ws + WS_RC);
    for (int row = blockIdx.x * 8 + wave; row < (WHICH == 0 ? MP : MTOK); row += gridDim.x * 8) {
        if (row >= MTOK) {
#pragma unroll
            for (int j = 0; j < 8; ++j) { u32x2 z = {0u, 0u}; *(u32x2*)(u2 + (size_t)row * D + j * 256 + lane * 4) = z; }
            continue; }
        float* xr = P.out + (size_t)row * D; f32x4 v[8]; float sm = 0.f;
#pragma unroll
        for (int j = 0; j < 8; ++j) { v[j] = *(const f32x4*)(xr + j * 256 + lane * 4); sm += (v[j][0] + v[j][1]) + (v[j][2] + v[j][3]); }
        const float mean = wave_sum(sm) * (1.0f / D); float q = 0.f;
#pragma unroll
        for (int j = 0; j < 8; ++j) { v[j] = v[j] - mean; q += (v[j][0] * v[j][0] + v[j][1] * v[j][1]) + (v[j][2] * v[j][2] + v[j][3] * v[j][3]); }
        const float rs = rsqrtf(wave_sum(q) * (1.0f / D) + 1e-5f);
        const float* ar = ada + (size_t)ada_row(row) * NADA;
#pragma unroll
        for (int j = 0; j < 8; ++j) { const int c = j * 256 + lane * 4; const f32x4 y = v[j] * rs * *(const f32x4*)(lw + c) + *(const f32x4*)(lb + c);
            *(f32x4*)(xr + c) = y;
            if (WHICH == 0) { const f32x4 o = y * (*(const f32x4*)(ar + 4 * D + c) + 1.0f) + *(const f32x4*)(ar + 3 * D + c);
                u32x2 w; w.x = cvt_pk_bf16(o[0], o[1]); w.y = cvt_pk_bf16(o[2], o[3]); *(u32x2*)(u2 + (size_t)row * D + c) = w; } }
    }
}
static __device__ __forceinline__ void phase_conv(const Params& P) {
    const bf16_t* hb = (const bf16_t*)(P.ws + WS_RA); bf16_t* g = (bf16_t*)(P.ws + WS_RB);
    const float* cw = P.in[I_CONVW]; const float* cb = P.in[I_CONVB]; const float* sc = P.in[I_SCONV];
    const size_t gtid = (size_t)blockIdx.x * 512 + threadIdx.x, gsz = (size_t)gridDim.x * 512;
    for (size_t i = gtid; i < (size_t)MP * (DFF / 8); i += gsz) { const int row = (int)(i / (DFF / 8)), c = (int)(i % (DFF / 8)) * 8; u32x4 w = {0u, 0u, 0u, 0u};
        if (row < MTOK) { float y[2][8];
#pragma unroll
            for (int half = 0; half < 2; ++half) { const int cc = c + half * DFF; float h2[8], h1[8], h0[8];
                const u32x4 t0 = *(const u32x4*)(hb + (size_t)row * F2 + cc); const unsigned t0a[4] = {t0.x, t0.y, t0.z, t0.w};
#pragma unroll
                for (int e = 0; e < 4; ++e) { h0[2 * e] = lo_bf(t0a[e]); h0[2 * e + 1] = hi_bf(t0a[e]); }
                if (row < MPR) { const int t = row & (SEQ - 1); u32x4 t1 = {0u, 0u, 0u, 0u}, t2 = {0u, 0u, 0u, 0u};
                    if (t >= 1) t1 = *(const u32x4*)(hb + (size_t)(row - 1) * F2 + cc);
                    if (t >= 2) t2 = *(const u32x4*)(hb + (size_t)(row - 2) * F2 + cc);
                    const unsigned t1a[4] = {t1.x, t1.y, t1.z, t1.w}, t2a[4] = {t2.x, t2.y, t2.z, t2.w};
#pragma unroll
                    for (int e = 0; e < 4; ++e) { h1[2 * e] = lo_bf(t1a[e]); h1[2 * e + 1] = hi_bf(t1a[e]); h2[2 * e] = lo_bf(t2a[e]); h2[2 * e + 1] = hi_bf(t2a[e]); } }
                else { const float* s0 = sc + ((size_t)(row - MPR) * 2) * F2 + cc; const float* s1 = s0 + F2;
#pragma unroll
                    for (int e = 0; e < 8; ++e) { h2[e] = s0[e]; h1[e] = s1[e]; } }
#pragma unroll
                for (int e = 0; e < 8; ++e) y[half][e] = cb[cc + e] + cw[cc + e] * h2[e] + cw[F2 + cc + e] * h1[e] + cw[2 * F2 + cc + e] * h0[e]; }
            float o[8];
#pragma unroll
            for (int e = 0; e < 8; ++e) o[e] = y[0][e] * sigmoidf_(y[0][e]) * y[1][e];
            w.x = cvt_pk_bf16(o[0], o[1]); w.y = cvt_pk_bf16(o[2], o[3]); w.z = cvt_pk_bf16(o[4], o[5]); w.w = cvt_pk_bf16(o[6], o[7]); }
        *(u32x4*)(g + (size_t)row * DFF + c) = w; }
    for (size_t i = gtid; i < (size_t)NS * F2; i += gsz) { const int r = (int)(i / F2), c = (int)(i % F2); P.out[O_CONVS + ((size_t)r * 2) * F2 + c] = sc[((size_t)r * 2 + 1) * F2 + c]; }
}

template <class Epi> __device__ __forceinline__ void run_gemm(unsigned char* smem, const bf16_t* A, const bf16_t* Bt, int M, int N, int K, const Epi& E) {
    pg8::Gemm g{A, Bt, M, N, K}; pg8::StaticOrder S; S.init(M, N, (int)gridDim.x, (int)blockIdx.x);
    pg8::gemm_phase<Epi, pg8::StaticOrder, false>((PG8_LAS unsigned char*)smem, g, S, E, nullptr);
}

__global__ void __launch_bounds__(512) fwd_kernel(Params P) {
    extern __shared__ __attribute__((aligned(16))) unsigned char smem[];
    cg::grid_group grid = cg::this_grid();
    const int lo = P.ph_lo, hi = P.ph_hi;
    unsigned char* ws = P.ws;
    const int G = (int)gridDim.x, bx = (int)blockIdx.x;
#define PH(k) (lo <= (k) && (k) < hi)
#define SEAM(k) do { if ((k) + 1 < hi) grid.sync(); } while (0)
    if (PH(0)) { transpose_job(P.in[I_WADA], D, NADA, (bf16_t*)(ws + WS_RA), 1 << 30, 0, bx, G, (float*)smem); phase_misc0(P); SEAM(0); }
    if (PH(1)) {
        EpiAda E{(float*)(ws + WS_ADA), P.in[I_BADA]};
        run_gemm(smem, (const bf16_t*)(ws + WS_AADA), (const bf16_t*)(ws + WS_RA), 256, NADA, D, E);
        const int first = G > 96 ? 48 : 0;
        if (bx >= first) { const int part = bx - first, np = G - first;
            transpose_job(P.in[I_WIN], D, 11552, (bf16_t*)(ws + WS_WIN), PRW, C_Q - PRW, part, np, (float*)smem);
            phase_misc1(P, (size_t)part * 512 + threadIdx.x, (size_t)np * 512); }
        SEAM(1); }
    if (PH(2)) { phase_modulate(P); SEAM(2); }
    if (PH(3)) { EpiBf16P E{(bf16_t*)(ws + WS_RA), NINP}; run_gemm(smem, (const bf16_t*)(ws + WS_RC), (const bf16_t*)(ws + WS_WIN), MP, NINP, D, E); SEAM(3); }
    if (PH(4)) { phase_lora_in(P); SEAM(4); }
    if (PH(5)) { float* dec = (float*)(ws + WS_RB); EpiLora E{dec, dec + (size_t)MP * RW, (bf16_t*)(dec + (size_t)2 * MP * RW), P.in[I_W0], P.in[I_A0]};
        run_gemm(smem, (const bf16_t*)(ws + WS_ALORA), (const bf16_t*)(ws + WS_WLORA), MP, NL, KL, E); SEAM(5); }
    if (PH(6)) {
        const bool split = G >= 64; int part = bx, np = G;
        if (split) { if (bx < 32) ret_prompt_item(P, bx >> 3, bx & 7, smem); part = bx - 32; np = G - 32; }
        else for (int it = bx; it < 32; it += G) ret_prompt_item(P, it >> 3, it & 7, smem);
        if (!split || bx >= 32) {
            transpose_job(P.in[I_WBA], RW, D, (bf16_t*)(ws + WS_WBA), 1 << 30, 0, part, np, (float*)smem);
            transpose_job(P.in[I_WBB], RW, D, (bf16_t*)(ws + WS_WBB), 1 << 30, 0, part, np, (float*)smem);
            transpose_job(P.in[I_WOUT], D, D, (bf16_t*)(ws + WS_WOUT), 1 << 30, 0, part, np, (float*)smem);
            transpose_job(P.in[I_WUP], D, F2, (bf16_t*)(ws + WS_WUP), 1 << 30, 0, part, np, (float*)smem);
            transpose_job(P.in[I_WDOWN], DFF, D, (bf16_t*)(ws + WS_WDOWN), 1 << 30, 0, part, np, (float*)smem);
            for (int pr = part; pr < NS * 8; pr += np) ret_sample_pair(P, pr, smem); }
        SEAM(6); }
    if (PH(7)) { for (int it = bx; it < 256; it += G) rwkv_prompt_item(P, it, smem);
        for (int pr = bx * 8 + (int)(threadIdx.x >> 6); pr < NS * 16; pr += G * 8) rwkv_sample_pair(P, pr);
        SEAM(7); }
    if (PH(8)) { phase_post(P); SEAM(8); }
    if (PH(9)) { const bf16_t* ya = (const bf16_t*)(ws + WS_RD);
        EpiBranch<0> E0{(const bf16_t*)(ws + WS_RA), P.out, (bf16_t*)(ws + WS_RC)}; run_gemm(smem, ya, (const bf16_t*)(ws + WS_WBA), MP, D, RW, E0);
        EpiBranch<1> E1{(const bf16_t*)(ws + WS_RA), P.out, (bf16_t*)(ws + WS_RC)}; run_gemm(smem, ya + (size_t)MP * RW, (const bf16_t*)(ws + WS_WBB), MP, D, RW, E1);
        SEAM(9); }
    if (PH(10)) { EpiRes<0> E{P.in[I_XP], P.in[I_XS], (const float*)(ws + WS_ADA), P.out}; run_gemm(smem, (const bf16_t*)(ws + WS_RC), (const bf16_t*)(ws + WS_WOUT), MP, D, D, E); SEAM(10); }
    if (PH(11)) { phase_ln<0>(P); SEAM(11); }
    if (PH(12)) { EpiUp E{(bf16_t*)(ws + WS_RA), P.out}; run_gemm(smem, (const bf16_t*)(ws + WS_RC), (const bf16_t*)(ws + WS_WUP), MP, F2, D, E); SEAM(12); }
    if (PH(13)) { phase_conv(P); SEAM(13); }
    if (PH(14)) { EpiRes<1> E{P.in[I_XP], P.in[I_XS], (const float*)(ws + WS_ADA), P.out}; run_gemm(smem, (const bf16_t*)(ws + WS_RB), (const bf16_t*)(ws + WS_WDOWN), MP, D, DFF, E); SEAM(14); }
    if (PH(15)) { phase_ln<1>(P); }
#undef PH
#undef SEAM
}

extern "C" void kernel_launch(void* const* d_in, const int* in_sizes, int n_in, void* d_out, int out_size, void* d_ws, size_t ws_size, hipStream_t stream) {
    static int grid = 0;
    if (grid == 0) {
        if (n_in != 35 || (size_t)out_size != O_END || ws_size < WS_END) { fprintf(stderr, "kernel_launch: unexpected shapes: n_in %d out %d ws %zu (need %zu)\n", n_in, out_size, ws_size, (size_t)WS_END); grid = -1; return; }
        int dev = 0, cus = 0, per_cu = 0;
        hipGetDevice(&dev); hipDeviceGetAttribute(&cus, hipDeviceAttributeMultiprocessorCount, dev);
        if (hipFuncSetAttribute((const void*)fwd_kernel, hipFuncAttributeMaxDynamicSharedMemorySize, LDS_BYTES) != hipSuccess) { fprintf(stderr, "kernel_launch: hipFuncSetAttribute failed\n"); grid = -1; return; }
        if (hipOccupancyMaxActiveBlocksPerMultiprocessor(&per_cu, (const void*)fwd_kernel, 512, LDS_BYTES) != hipSuccess || per_cu < 1) { fprintf(stderr, "kernel_launch: occupancy query failed (%d)\n", per_cu); (void)hipGetLastError(); per_cu = 1; }
        grid = cus * 1;
        if (grid <= 0) { grid = -1; return; }
    }
    if (grid < 0) return;
    Params p{};
    for (int i = 0; i < 35; ++i) p.in[i] = (const float*)d_in[i];
    p.out = (float*)d_out; p.ws = (unsigned char*)d_ws;
#if MULTI
    for (int ph = 0; ph <= NPHASE; ++ph) { p.ph_lo = ph; p.ph_hi = ph + 1; hipLaunchKernelGGL(fwd_kernel, dim3(grid), dim3(512), LDS_BYTES, stream, p); }
#else
    p.ph_lo = 0; p.ph_hi = NPHASE + 1;
    void* args[] = {&p};
    hipError_t e = hipLaunchCooperativeKernel((const void*)fwd_kernel, dim3(grid), dim3(512), args, LDS_BYTES, stream);
    if (e != hipSuccess) fprintf(stderr, "cooperative launch failed: %s (grid %d)\n", hipGetErrorString(e), grid);
#endif
}
```

```cpp
#include <hip/hip_runtime.h>
#include <hip/hip_cooperative_groups.h>
#include <cstdio>
namespace cg = cooperative_groups;
#define MULTI 0
#define DUPK -1
#define DUPS 1
namespace pg8 {
#define PG8_LAS __attribute__((address_space(3)))
typedef unsigned short bf16_t;
typedef short bf16x8 __attribute__((ext_vector_type(8)));
typedef float f32x4 __attribute__((ext_vector_type(4)));
typedef unsigned u32x4 __attribute__((ext_vector_type(4)));
constexpr int BM = 256, BK = 64, HALF = 128, HTB = HALF * BK * 2  , STAGE_BYTES = 8 * HTB, NXCD = 8, WGM = 8;

__host__ __device__ __forceinline__ int lds_byte(int r, int c) { const int st = (r >> 4) * 2 + (c >> 5), rr = r & 15, cc = c & 31, ob = rr * 64 + cc * 2; return st * 1024 + (ob ^ (((ob >> 9) & 1) << 5)); }
__host__ __device__ __forceinline__ void stage_rc(int b, int& R, int& C) { const int st = b / 1024, sb = b % 1024, swz = sb ^ (((sb >> 9) & 1) << 5); R = (st >> 1) * 16 + swz / 64; C = (st & 1) * 32 + (swz % 64) / 2; }
__host__ __device__ __forceinline__ int perm32(int rho) { const int n = rho >> 4, i = rho & 15; return 8 * (i >> 2) + 4 * n + (i & 3); }

struct Unit { int pm, pn, k0; };
struct Gemm { const bf16_t* A; const bf16_t* Bt; int M, N, K, ld; };

struct StaticOrder {
    int nM, nN, nwg, G, c;
    __host__ __device__ void init(int M, int N, int G_, int c_) { nM = M / BM; nN = N / BM; nwg = nM * nN; G = G_; c = c_; }
    __host__ __device__ bool next(int i, Unit& u) const {
        const long L = (long)i * G + c; if (L >= nwg) return false;
        int wgid = (int)L; { const int q = nwg / NXCD, r = nwg % NXCD, xcd = wgid % NXCD, off = wgid / NXCD; wgid = (xcd < r ? xcd * (q + 1) : r * (q + 1) + (xcd - r) * q) + off; }
        const int nig = WGM * nN, gid = wgid / nig, fm = gid * WGM, gsz = (nM - fm) < WGM ? (nM - fm) : WGM;
        u.pm = fm + ((wgid % nig) % gsz); u.pn = (wgid % nig) / gsz; u.k0 = 0; return true;
    }
    __device__ __forceinline__ void a_ready(const Unit&) const {}
    __device__ __forceinline__ void done(const Unit&) const {}
};
__device__ __forceinline__ unsigned cvt_pk_bf16(float lo, float hi) { unsigned r; asm volatile("v_cvt_pk_bf16_f32 %0, %1, %2" : "=v"(r) : "v"(lo), "v"(hi)); return r; }
typedef float f32x2 __attribute__((ext_vector_type(2)));
template <class Epi, class Sched, bool STAMP = false>
__device__ __forceinline__ void gemm_phase(PG8_LAS unsigned char* lds, const Gemm g, const Sched& S, const Epi& E, unsigned long long* stamps) {
    const int tid = threadIdx.x, wid = __builtin_amdgcn_readfirstlane(tid >> 6), lane = tid & 63, wr = wid >> 2, wc = wid & 3, fr = lane & 15, fq = lane >> 4;
    const int K = g.K, nt = K / BK, LD = g.ld;
    int ts_lo = 0, ts_hi = 0, nts = 0; const unsigned long long rt_entry = STAMP ? (unsigned long long)wall_clock64() : 0ull;
#define PG8_STAMP() do { if (STAMP && wid == 0 && nts < 64) { const unsigned long long _c = (unsigned long long)clock64(); \
        ts_lo = (lane == nts) ? (int)(unsigned)_c : ts_lo; ts_hi = (lane == nts) ? (int)(unsigned)(_c >> 32) : ts_hi; ++nts; } } while (0)
    PG8_STAMP();
    unsigned voffA[2], voffB[2];
#pragma unroll
    for (int i = 0; i < 2; ++i) { int R, C; stage_rc(tid * 16 + i * 8192, R, C); const int Rb = Epi::PERM ? ((R & ~31) + perm32(R & 31)) : R;
        voffA[i] = (unsigned)(R * LD + C) * 2u; voffB[i] = (unsigned)(Rb * LD + C) * 2u; }
    const size_t kstep = (size_t)(BK * 2);
    const size_t hstep = (size_t)HALF * LD * 2;
    const size_t tstep = 2 * hstep;
    const unsigned ldsw = (unsigned)wid * 1024u;
    const int aoff = lds_byte(wr * 64 + fr, fq * 8), boff = lds_byte(wc * 32 + fr, fq * 8);
#define PG8_SA(b, h) (((b) * 2 + (h)) * HTB)
#define PG8_SB(b, h) ((4 + (b) * 2 + (h)) * HTB)
#define PG8_STAGE(bufoff, gbase, voff) do { _Pragma("unroll") for (int _i = 0; _i < 2; ++_i) \
        __builtin_amdgcn_global_load_lds((const unsigned*)((const char*)(gbase) + (voff)[_i]), (PG8_LAS unsigned*)(lds + (bufoff) + ldsw + _i * 8192), 16, 0, 0); } while (0)
#define PG8_LDA(dst, b, h) do { _Pragma("unroll") for (int m = 0; m < 4; ++m) _Pragma("unroll") for (int k = 0; k < 2; ++k) dst[m][k] = *(const PG8_LAS bf16x8*)(lds + PG8_SA(b, h) + aoff + m * 2048 + k * 1024); } while (0)
#define PG8_LDB(dst, b, h) do { _Pragma("unroll") for (int n = 0; n < 2; ++n) _Pragma("unroll") for (int k = 0; k < 2; ++k) dst[n][k] = *(const PG8_LAS bf16x8*)(lds + PG8_SB(b, h) + boff + n * 2048 + k * 1024); } while (0)
#define PG8_MMA(ai, bj, At, Bt) do { __builtin_amdgcn_s_setprio(1); _Pragma("unroll") for (int m = 0; m < 4; ++m) _Pragma("unroll") for (int n = 0; n < 2; ++n) _Pragma("unroll") for (int k = 0; k < 2; ++k) \
        acc[ai][bj][m][n] = __builtin_amdgcn_mfma_f32_16x16x32_bf16(Bt[n][k], At[m][k], acc[ai][bj][m][n], 0, 0, 0); __builtin_amdgcn_s_setprio(0); } while (0)
#define PG8_WAIT_V(n) asm volatile("s_waitcnt vmcnt(" #n ")" ::: "memory")
#define PG8_WAIT_L(n) asm volatile("s_waitcnt lgkmcnt(" #n ")" ::: "memory")
#define PG8_BAR __builtin_amdgcn_s_barrier()
#define PG8_SCHED __builtin_amdgcn_sched_barrier(0)
    Unit cur, nxt; int ui = 0;
    if (!S.next(0, cur)) return;
    f32x4 acc[2][2][4][2];
#pragma unroll
    for (int a = 0; a < 2; ++a)
#pragma unroll
        for (int b = 0; b < 2; ++b)
#pragma unroll
            for (int m = 0; m < 4; ++m)
#pragma unroll
                for (int n = 0; n < 2; ++n) acc[a][b][m][n] = (f32x4){0.f, 0.f, 0.f, 0.f};
    bf16x8 At[4][2], B0[2][2], B1[2][2];
    const char* cA = (const char*)g.A + (size_t)cur.pm * tstep + (size_t)cur.k0 * 2; const char* cB = (const char*)g.Bt + (size_t)cur.pn * tstep + (size_t)cur.k0 * 2;
    S.a_ready(cur);
    PG8_STAGE(PG8_SB(0, 0), cB, voffB); PG8_STAGE(PG8_SA(0, 0), cA, voffA); PG8_STAGE(PG8_SB(0, 1), cB + hstep, voffB); PG8_STAGE(PG8_SA(0, 1), cA + hstep, voffA);
    if (wr == 1) PG8_BAR;
    PG8_WAIT_V(4); PG8_BAR;
    PG8_STAGE(PG8_SB(1, 0), cB + kstep, voffB); PG8_STAGE(PG8_SA(1, 0), cA + kstep, voffA); PG8_STAGE(PG8_SB(1, 1), cB + hstep + kstep, voffB);
    PG8_WAIT_V(6); PG8_BAR;
    PG8_STAMP();
    for (;;) {
        const bool has_next = S.next(ui + 1, nxt);
        const char* nA = has_next ? (const char*)g.A + (size_t)nxt.pm * tstep + (size_t)nxt.k0 * 2 : cA; const char* nB = has_next ? (const char*)g.Bt + (size_t)nxt.pn * tstep + (size_t)nxt.k0 * 2 : cB;
        for (int hk = 0; hk < (Epi::HAS_MID ? 2 : 1); ++hk) {
        const int tb = Epi::HAS_MID ? hk * (nt / 2) : 0, te = Epi::HAS_MID ? tb + nt / 2 : nt;
        for (int t = tb; t < te; t += 2) {
            const bool last = (t == nt - 2);
            const char* a1 = cA + (size_t)(t + 1) * kstep;
            const char* a2 = last ? nA : cA + (size_t)(t + 2) * kstep; const char* b2 = last ? nB : cB + (size_t)(t + 2) * kstep;
            const char* a3 = a2 + kstep; const char* b3 = b2 + kstep;
            if (last && has_next) S.a_ready(nxt);
            PG8_LDB(B0, 0, 0); PG8_SCHED; PG8_LDA(At, 0, 0); PG8_STAGE(PG8_SA(1, 1), a1 + hstep, voffA);
            PG8_WAIT_L(8); PG8_BAR; PG8_WAIT_L(0); PG8_MMA(0, 0, At, B0); PG8_BAR; PG8_SCHED;
            PG8_LDB(B1, 0, 1); PG8_STAGE(PG8_SB(0, 0), b2, voffB);
            PG8_BAR; PG8_WAIT_L(0); PG8_MMA(0, 1, At, B1); PG8_BAR;
            PG8_LDA(At, 0, 1); PG8_STAGE(PG8_SA(0, 0), a2, voffA);
            PG8_BAR; PG8_WAIT_L(0); PG8_MMA(1, 0, At, B0); PG8_BAR; PG8_SCHED;
            PG8_STAGE(PG8_SB(0, 1), b2 + hstep, voffB);
            PG8_WAIT_V(6); PG8_BAR; PG8_MMA(1, 1, At, B1); PG8_BAR;
            PG8_LDB(B0, 1, 0); PG8_SCHED; PG8_LDA(At, 1, 0); PG8_STAGE(PG8_SA(0, 1), a2 + hstep, voffA);
            PG8_WAIT_L(8); PG8_BAR; PG8_WAIT_L(0); PG8_MMA(0, 0, At, B0); PG8_BAR; PG8_SCHED;
            PG8_LDB(B1, 1, 1); PG8_STAGE(PG8_SB(1, 0), b3, voffB);
            PG8_BAR; PG8_WAIT_L(0); PG8_MMA(0, 1, At, B1); PG8_BAR;
            PG8_LDA(At, 1, 1); PG8_STAGE(PG8_SA(1, 0), a3, voffA);
            PG8_BAR; PG8_WAIT_L(0); PG8_MMA(1, 0, At, B0); PG8_BAR; PG8_SCHED;
            PG8_STAGE(PG8_SB(1, 1), b3 + hstep, voffB);
            PG8_WAIT_V(6); PG8_BAR; PG8_MMA(1, 1, At, B1); PG8_BAR;
        }
        if constexpr (Epi::HAS_MID) { if (hk == 0) E.mid(acc, cur, wr, wc, fr, fq); }
        }
        PG8_STAMP();
        if constexpr (!Epi::AFTER_DRAIN) { E(acc, cur, wr, wc, fr, fq); S.done(cur); }
        PG8_STAMP();
        if (!has_next) break;
#pragma unroll
        for (int a = 0; a < 2; ++a)
#pragma unroll
            for (int b = 0; b < 2; ++b)
#pragma unroll
                for (int m = 0; m < 4; ++m)
#pragma unroll
                    for (int n = 0; n < 2; ++n) acc[a][b][m][n] = (f32x4){0.f, 0.f, 0.f, 0.f};
        cur = nxt; cA = nA; cB = nB; ++ui;
    }
    PG8_WAIT_V(0);
    if (wr == 0) PG8_BAR;
    PG8_BAR;
    if constexpr (Epi::AFTER_DRAIN) { E.fused(acc, cur, wr, wc, fr, fq, lds, wid, lane); S.done(cur); }
    PG8_STAMP();
    if (STAMP && wid == 0) { stamps[lane] = lane < nts ? (((unsigned long long)(unsigned)ts_hi << 32) | (unsigned)ts_lo) : 0ull;
        if (lane == 62) stamps[62] = rt_entry; if (lane == 63) stamps[63] = (unsigned long long)wall_clock64(); }
#undef PG8_STAMP
#undef PG8_SA
#undef PG8_SB
#undef PG8_STAGE
#undef PG8_LDA
#undef PG8_LDB
#undef PG8_MMA
#undef PG8_WAIT_V
#undef PG8_WAIT_L
#undef PG8_BAR
#undef PG8_SCHED
}
}

using pg8::bf16_t; using pg8::f32x4; using pg8::u32x4; using pg8::Unit; using pg8::BM; using pg8::HALF; using pg8::cvt_pk_bf16; using pg8::bf16x8;
typedef unsigned u32x2 __attribute__((ext_vector_type(2)));

#ifndef MULTI
#define MULTI 0
#endif

constexpr int D = 2048, SEQ = 2048, NB = 4, NS = 128;
constexpr int MPR = NB * SEQ;
constexpr int MTOK = MPR + NS;
constexpr int MP = 8448;
constexpr int RW = 1024, PRW = 3360;
constexpr int NINP = 11776;
constexpr int C_Q = 3584, C_K = 4608, C_V = 5632, C_RG = 6656, C_GA = 7680, C_GB = 9728;
constexpr int F2 = 11264, DFF = 5632;
constexpr int KL = 384, NL = 3072;
constexpr int NADA = 12288;
constexpr float ALPHA = 1.189207115002721f;
constexpr int NPHASE = 15;
constexpr int LDS_BYTES = 131072 + 1024;

constexpr size_t O_YP = 0;
constexpr size_t O_YS = O_YP + (size_t)MPR * D;
constexpr size_t O_WKVP = O_YS + (size_t)NS * D;
constexpr size_t O_SHIFTP = O_WKVP + (size_t)NB * 16 * 64 * 64;
constexpr size_t O_RETP = O_SHIFTP + (size_t)NB * PRW;
constexpr size_t O_CONVP = O_RETP + (size_t)NB * 8 * 128 * 128;
constexpr size_t O_WKVS = O_CONVP + (size_t)NB * 2 * F2;
constexpr size_t O_SHIFTS = O_WKVS + (size_t)NS * 16 * 64 * 64;
constexpr size_t O_RETS = O_SHIFTS + (size_t)NS * PRW;
constexpr size_t O_CONVS = O_RETS + (size_t)NS * 8 * 128 * 128;
constexpr size_t O_END = O_CONVS + (size_t)NS * 2 * F2;

constexpr size_t al256(size_t x) { return (x + 255) & ~(size_t)255; }
constexpr size_t WS_WIN = 0;
constexpr size_t WS_WUP = al256(WS_WIN + (size_t)NINP * D * 2);
constexpr size_t WS_WDOWN = al256(WS_WUP + (size_t)F2 * D * 2);
constexpr size_t WS_WOUT = al256(WS_WDOWN + (size_t)D * DFF * 2);
constexpr size_t WS_WBA = al256(WS_WOUT + (size_t)D * D * 2);
constexpr size_t WS_WBB = al256(WS_WBA + (size_t)D * RW * 2);
constexpr size_t WS_WLORA = al256(WS_WBB + (size_t)D * RW * 2);
constexpr size_t WS_ADA = al256(WS_WLORA + (size_t)NL * KL * 2);
constexpr size_t WS_AADA = al256(WS_ADA + (size_t)132 * NADA * 4);
constexpr size_t WS_ROPE = al256(WS_AADA + (size_t)256 * D * 2);
constexpr size_t WS_BONUS = al256(WS_ROPE + (size_t)2049 * 64 * 4 * 2);
constexpr size_t WS_ALORA = al256(WS_BONUS + (size_t)MTOK * 16 * 4);
constexpr size_t WS_RC = al256(WS_ALORA + (size_t)MP * KL * 2);
constexpr size_t WS_RD = al256(WS_RC + (size_t)MP * D * 2);
constexpr size_t WS_RA = al256(WS_RD + (size_t)MP * D * 2);
constexpr size_t WS_RB = al256(WS_RA + (size_t)MP * NINP * 2);
constexpr size_t WS_ACC = al256(WS_RB + (size_t)MP * DFF * 2);
constexpr size_t WS_BAR = al256(WS_ACC + (size_t)4 * NS * D * 4);
constexpr size_t WS_END = al256(WS_BAR + (size_t)4 * 3456 * 4);

#ifndef DUPK
#define DUPK -1
#endif
struct Params { const float* in[35]; float* out; unsigned char* ws; int ph_lo, ph_hi, li, pad; };

enum { I_XP = 0, I_XS, I_CP, I_CS, I_SWKV, I_SSHIFT, I_SRET, I_SCONV, I_WADA, I_BADA, I_WIN, I_MU, I_W0, I_WDEC, I_A0, I_WAAA, I_WGATE, I_KK, I_KA, I_RK,
       I_LNXW, I_LNXB, I_RGNW, I_RGNB, I_WBA, I_WBB, I_WOUT, I_LN1W, I_LN1B, I_WUP, I_CONVW, I_CONVB, I_WDOWN, I_LN2W, I_LN2B };

__device__ __forceinline__ float bf2f(bf16_t v) { return __uint_as_float(((unsigned)v) << 16); }
__device__ __forceinline__ bf16_t f2bf(float f) { unsigned u = __float_as_uint(f); u += 0x7FFFu + ((u >> 16) & 1u); return (bf16_t)(u >> 16); }
__device__ __forceinline__ float lo_bf(unsigned w) { return __uint_as_float(w << 16); }
__device__ __forceinline__ float hi_bf(unsigned w) { return __uint_as_float(w & 0xffff0000u); }
template <int CTRL> __device__ __forceinline__ float dpp_f(float x) { return __int_as_float(__builtin_amdgcn_update_dpp(0, __float_as_int(x), CTRL, 0xF, 0xF, true)); }
__device__ __forceinline__ float row16_sum(float x) { x += dpp_f<0xB1>(x); x += dpp_f<0x4E>(x); x += dpp_f<0x141>(x); x += dpp_f<0x140>(x); return x; }
__device__ __forceinline__ float wave_sum(float x) {
    x = row16_sum(x); const int xi = __float_as_int(x);
    const float a = __int_as_float(__builtin_amdgcn_readlane(xi, 0)), b = __int_as_float(__builtin_amdgcn_readlane(xi, 16)), c = __int_as_float(__builtin_amdgcn_readlane(xi, 32)), d = __int_as_float(__builtin_amdgcn_readlane(xi, 48));
    return (a + b) + (c + d);
}
__device__ __forceinline__ float sigmoidf_(float x) { return __builtin_amdgcn_rcpf(1.0f + __expf(-x)); }
__device__ __forceinline__ int ada_row(int row) { return row < MPR ? (row >> 11) : 4 + (row - MPR); }


#define XB_TMO      128
#define XB_XCNT(j)  (256  + 64 * (j))
#define XB_XSUB(j)  (1280 + 64 * (j))
#define XB_XGEN(j)  (2304 + 64 * (j))
#define XB_TOP      3328
#define XB_TOPGEN   3392
#define XCD_BAR_WORDS 3456
#define XB_SPIN_CAP (1u << 18)
#define LAS __attribute__((address_space(3)))
__device__ __forceinline__ unsigned xb_ld(unsigned* p)              { return __hip_atomic_load(p, __ATOMIC_RELAXED, __HIP_MEMORY_SCOPE_AGENT); }
__device__ __forceinline__ unsigned xb_add(unsigned* p, unsigned v) { return __hip_atomic_fetch_add(p, v, __ATOMIC_RELAXED, __HIP_MEMORY_SCOPE_AGENT); }
__device__ __forceinline__ unsigned xb_xcc_id() { return (unsigned)__builtin_amdgcn_s_getreg((3 << 11) | 20) & 0xFu; }
#define XB_SPIN(cond, bar) do { unsigned _sp = 0; while (cond) { __builtin_amdgcn_s_sleep(1); \
    if ((++_sp & 255u) == 0u) { if (xb_ld(&(bar)[XB_TMO])) break; if (_sp > XB_SPIN_CAP) { atomicAdd(&(bar)[XB_TMO], 1u); break; } } } } while (0)
struct XcdBarrier { unsigned* bar; unsigned x; volatile LAS unsigned* st; };
__device__ __forceinline__ XcdBarrier xcd_barrier_post(unsigned* bar, volatile LAS unsigned* st) {
    XcdBarrier b; b.bar = bar; b.x = xb_xcc_id(); b.st = st;
    if (threadIdx.x == 0) (void)xb_add(&bar[XB_XCNT(b.x)], 1u);
    return b;
}
__device__ __forceinline__ void xcd_barrier_complete(unsigned* bar, unsigned x, unsigned& nloc, unsigned& nx) {
    const unsigned G = gridDim.x * gridDim.y * gridDim.z;
    unsigned sum, cnt, mine, sp = 0u;
    for (;;) {
        sum = 0u; cnt = 0u; mine = 0u;
#pragma unroll
        for (unsigned j = 0; j < 16; ++j) { const unsigned c = xb_ld(&bar[XB_XCNT(j)]); sum += c; cnt += (c > 0u) ? 1u : 0u; mine = (j == x) ? c : mine; }
        if (sum == G) break;
        __builtin_amdgcn_s_sleep(1);
        if ((++sp & 255u) == 0u) { if (xb_ld(&bar[XB_TMO])) break; if (sp > XB_SPIN_CAP) { atomicAdd(&bar[XB_TMO], 1u); break; } }
    }
    nloc = mine > 0u ? mine : 1u; nx = cnt > 0u ? cnt : 1u;
}
__device__ __forceinline__ void xcd_barrier(const XcdBarrier& b) {
    asm volatile("s_waitcnt vmcnt(0)" ::: "memory");
    __syncthreads();
    if (threadIdx.x == 0) {
        unsigned* bar = b.bar;
        __builtin_amdgcn_s_waitcnt(0);
        unsigned nloc = b.st[0], nx = b.st[1];
        if (nloc == 0u) { xcd_barrier_complete(bar, b.x, nloc, nx); b.st[0] = nloc; b.st[1] = nx; }
        const unsigned old = xb_add(&bar[XB_XSUB(b.x)], 1u);
        const unsigned gen = old / nloc;
        if (old + 1u == (gen + 1u) * nloc) {
            __builtin_amdgcn_fence(__ATOMIC_RELEASE, "agent");
            asm volatile("s_waitcnt vmcnt(0)" ::: "memory");
            const unsigned og = xb_add(&bar[XB_TOP], 1u);
            const unsigned tg = og / nx;
            if (og + 1u == (tg + 1u) * nx) xb_add(&bar[XB_TOPGEN], 1u);
            else XB_SPIN(xb_ld(&bar[XB_TOPGEN]) == tg, bar);
            __builtin_amdgcn_fence(__ATOMIC_ACQUIRE, "agent");
            xb_add(&bar[XB_XGEN(b.x)], 1u);
            asm volatile("s_waitcnt vmcnt(0)" ::: "memory");
        } else {
            XB_SPIN(xb_ld(&bar[XB_XGEN(b.x)]) == gen, bar);
            __builtin_amdgcn_fence(__ATOMIC_ACQUIRE, "agent");
            asm volatile("s_waitcnt vmcnt(0)" ::: "memory");
        }
    }
    __syncthreads();
}

#define RW_BAR() do { asm volatile("s_waitcnt lgkmcnt(0)" ::: "memory"); __builtin_amdgcn_s_barrier(); asm volatile("" ::: "memory"); } while (0)
static __device__ __forceinline__ void transpose_job(const float* __restrict__ W, int K, int N, bf16_t* __restrict__ Wt, int shift_from, int shift, int part, int nparts, float* tl, int ldk = 0, int koff = 0) {
    if (ldk == 0) ldk = K;
    const int tid = threadIdx.x;
    const int nKt = K / 64, nNt = (N + 63) / 64, ntile = nKt * nNt;
    f32x4 v[4][2];
    const int li = tid >> 4, lj = (tid & 15) * 4;
#define TR_LOAD(t, q) do { if ((t) < ntile) { const int nt_ = (t) / nKt, kt_ = (t) - nt_ * nKt; const int n = nt_ * 64 + lj; \
        _Pragma("unroll") for (int e = 0; e < 2; ++e) v[q][e] = (n < N) ? __builtin_nontemporal_load((const f32x4*)(W + (size_t)(kt_ * 64 + li + e * 32) * N + n)) : (f32x4){0.f, 0.f, 0.f, 0.f}; } } while (0)
    int t = part;
#pragma unroll
    for (int q = 0; q < 4; ++q) TR_LOAD(t + q * nparts, q);
    for (; t < ntile; t += 4 * nparts) {
#pragma unroll
        for (int q = 0; q < 4; ++q) if (t + q * nparts < ntile) {
#pragma unroll
            for (int e = 0; e < 2; ++e) { float* d = tl + q * 4160 + (li + e * 32) * 65 + lj; d[0] = v[q][e][0]; d[1] = v[q][e][1]; d[2] = v[q][e][2]; d[3] = v[q][e][3]; } }
        RW_BAR();
#pragma unroll
        for (int q = 0; q < 4; ++q) TR_LOAD(t + (4 + q) * nparts, q);
#pragma unroll
        for (int q = 0; q < 4; ++q) { const int tq = t + q * nparts;
            if (tq < ntile) { const int nt = tq / nKt, kt = tq - nt * nKt, k0 = kt * 64, n0 = nt * 64; const float* s = tl + q * 4160;
#pragma unroll
                for (int e = 0; e < 4; ++e) { const int p = tid + e * 512, j = p >> 5, i = (p & 31) * 2, n = n0 + j;
                    if (n < N) { const int dr = (n >= shift_from) ? n + shift : n;
                        *(unsigned*)(Wt + (size_t)dr * ldk + koff + k0 + i) = cvt_pk_bf16(s[i * 65 + j], s[(i + 1) * 65 + j]); } } } }
        RW_BAR();
    }
#undef TR_LOAD
    __syncthreads();
}

struct SplitOrder { int nunits, G, c, ks, kbase;
    __device__ bool next(int i, Unit& u) const { const int L = i * G + c; if (L >= nunits) return false; u.pm = MPR / 256; u.pn = L & 7; u.k0 = kbase + (L >> 3) * ks; return true; }
    __device__ __forceinline__ void a_ready(const Unit&) const {}
    __device__ __forceinline__ void done(const Unit&) const {}
};
struct AdaOrder { int nunits, G, c;
    __device__ bool next(int i, Unit& u) const { const int L = i * G + c; if (L >= nunits) return false; u.pm = 0; u.pn = L % 48; u.k0 = (L / 48) * 1024; return true; }
    __device__ __forceinline__ void a_ready(const Unit&) const {}
    __device__ __forceinline__ void done(const Unit&) const {}
};
struct EpiAda { static constexpr bool HAS_MID = false, PERM = false, AFTER_DRAIN = false; float* ada; const float* b_ada;
    __device__ __forceinline__ void operator()(const f32x4 (&acc)[2][2][4][2], const Unit& u, int wr, int wc, int fr, int fq) const {
        const int row0 = u.pm * BM + wr * 64 + fr, col0 = u.pn * BM + wc * 32 + 4 * fq;
#pragma unroll
        for (int ai = 0; ai < 2; ++ai)
#pragma unroll
            for (int m = 0; m < 4; ++m) { const int row = row0 + ai * HALF + m * 16;
                if (row < 132) {
#pragma unroll
                    for (int bj = 0; bj < 2; ++bj)
#pragma unroll
                        for (int n = 0; n < 2; ++n) { const int col = col0 + bj * HALF + n * 16; f32x4 v = acc[ai][bj][m][n];
                            if (u.k0 == 0) v += *(const f32x4*)(b_ada + col);
                            float* p = ada + (size_t)row * NADA + col;
#pragma unroll
                            for (int j = 0; j < 4; ++j) unsafeAtomicAdd(p + j, v[j]); } } }
    }
};
struct EpiBf16P { static constexpr bool HAS_MID = false, PERM = true, AFTER_DRAIN = false; bf16_t* O; int ldc;
    __device__ __forceinline__ void operator()(const f32x4 (&acc)[2][2][4][2], const Unit& u, int wr, int wc, int fr, int fq) const {
        const int row0 = u.pm * BM + wr * 64 + fr, col0 = u.pn * BM + wc * 32 + 8 * fq;
#pragma unroll
        for (int ai = 0; ai < 2; ++ai)
#pragma unroll
            for (int m = 0; m < 4; ++m) { bf16_t* rowp = O + (size_t)(row0 + ai * HALF + m * 16) * ldc + col0;
#pragma unroll
                for (int bj = 0; bj < 2; ++bj) { const f32x4 v0 = acc[ai][bj][m][0], v1 = acc[ai][bj][m][1];
                    u32x4 w; w.x = cvt_pk_bf16(v0[0], v0[1]); w.y = cvt_pk_bf16(v0[2], v0[3]); w.z = cvt_pk_bf16(v1[0], v1[1]); w.w = cvt_pk_bf16(v1[2], v1[3]);
                    *(u32x4*)(rowp + bj * HALF) = w; } }
    }
};
struct EpiUp { static constexpr bool HAS_MID = false, PERM = true, AFTER_DRAIN = false; bf16_t* O; float* out;
    __device__ __forceinline__ void operator()(const f32x4 (&acc)[2][2][4][2], const Unit& u, int wr, int wc, int fr, int fq) const {
        const int row0 = u.pm * BM + wr * 64 + fr, col0 = u.pn * BM + wc * 32 + 8 * fq;
#pragma unroll
        for (int ai = 0; ai < 2; ++ai)
#pragma unroll
            for (int m = 0; m < 4; ++m) { const int row = row0 + ai * HALF + m * 16; bf16_t* rowp = O + (size_t)row * F2 + col0;
                float* cdst = nullptr;
                if (row < MPR) { const int t = row & (SEQ - 1); if (t >= SEQ - 2) cdst = out + O_CONVP + ((size_t)(row >> 11) * 2 + (t - (SEQ - 2))) * F2; }
                else if (row < MTOK) cdst = out + O_CONVS + ((size_t)(row - MPR) * 2 + 1) * F2;
#pragma unroll
                for (int bj = 0; bj < 2; ++bj) { const f32x4 v0 = acc[ai][bj][m][0], v1 = acc[ai][bj][m][1];
                    u32x4 w; w.x = cvt_pk_bf16(v0[0], v0[1]); w.y = cvt_pk_bf16(v0[2], v0[3]); w.z = cvt_pk_bf16(v1[0], v1[1]); w.w = cvt_pk_bf16(v1[2], v1[3]);
                    *(u32x4*)(rowp + bj * HALF) = w;
                    if (cdst) { *(f32x4*)(cdst + col0 + bj * HALF) = v0; *(f32x4*)(cdst + col0 + bj * HALF + 4) = v1; } } }
    }
};
struct EpiLora { static constexpr bool HAS_MID = false, PERM = false, AFTER_DRAIN = false; float* dec; float* aa; bf16_t* gg; const float* w0; const float* a0;
    __device__ __forceinline__ void operator()(const f32x4 (&acc)[2][2][4][2], const Unit& u, int wr, int wc, int fr, int fq) const {
        const int kind = u.pn >> 2;
        const int row0 = u.pm * BM + wr * 64 + fr, col0 = (u.pn & 3) * BM + wc * 32 + 4 * fq;
        if (kind == 0) {
#pragma unroll
            for (int ai = 0; ai < 2; ++ai)
#pragma unroll
                for (int m = 0; m < 4; ++m) { float* rp = dec + (size_t)(row0 + ai * HALF + m * 16) * RW + col0;
#pragma unroll
                    for (int bj = 0; bj < 2; ++bj)
#pragma unroll
                        for (int n = 0; n < 2; ++n) { const f32x4 v = acc[ai][bj][m][n]; f32x4 o; const f32x4 bb = *(const f32x4*)(w0 + col0 + bj * HALF + n * 16);
#pragma unroll
                            for (int j = 0; j < 4; ++j) { const float y = -(bb[j] + v[j]); const float sp = fmaxf(y, 0.f) + __logf(1.0f + __expf(-fabsf(y))); o[j] = __expf(-__expf(-sp - 0.5f)); }
                            *(f32x4*)(rp + bj * HALF + n * 16) = o; } }
        } else if (kind == 1) {
#pragma unroll
            for (int ai = 0; ai < 2; ++ai)
#pragma unroll
                for (int m = 0; m < 4; ++m) { float* rp = aa + (size_t)(row0 + ai * HALF + m * 16) * RW + col0;
#pragma unroll
                    for (int bj = 0; bj < 2; ++bj)
#pragma unroll
                        for (int n = 0; n < 2; ++n) { const f32x4 v = acc[ai][bj][m][n]; f32x4 o; const f32x4 bb = *(const f32x4*)(a0 + col0 + bj * HALF + n * 16);
#pragma unroll
                            for (int j = 0; j < 4; ++j) o[j] = sigmoidf_(bb[j] + v[j]);
                            *(f32x4*)(rp + bj * HALF + n * 16) = o; } }
        } else {
#pragma unroll
            for (int ai = 0; ai < 2; ++ai)
#pragma unroll
                for (int m = 0; m < 4; ++m) { bf16_t* rp = gg + (size_t)(row0 + ai * HALF + m * 16) * RW + col0;
#pragma unroll
                    for (int bj = 0; bj < 2; ++bj)
#pragma unroll
                        for (int n = 0; n < 2; ++n) { const f32x4 v = acc[ai][bj][m][n]; u32x2 w; w.x = cvt_pk_bf16(v[0], v[1]); w.y = cvt_pk_bf16(v[2], v[3]); *(u32x2*)(rp + bj * HALF + n * 16) = w; } }
        }
    }
};
struct EpiAtomic { static constexpr bool HAS_MID = false, PERM = false, AFTER_DRAIN = false; float* accb;
    __device__ __forceinline__ void operator()(const f32x4 (&acc)[2][2][4][2], const Unit& u, int wr, int wc, int fr, int fq) const {
        const int col0 = u.pn * BM + wc * 32 + 4 * fq;
#pragma unroll
        for (int m = 0; m < 4; ++m) { const int r = wr * 64 + m * 16 + fr;
#pragma unroll
            for (int bj = 0; bj < 2; ++bj)
#pragma unroll
                for (int n = 0; n < 2; ++n) { float* p = accb + (size_t)r * D + col0 + bj * HALF + n * 16; const f32x4 v = acc[0][bj][m][n];
#pragma unroll
                    for (int j = 0; j < 4; ++j) unsafeAtomicAdd(p + j, v[j]); } }
    }
};
struct EpiMerged { static constexpr bool HAS_MID = true, PERM = false, AFTER_DRAIN = false; const bf16_t* proj; bf16_t* merged;
    __device__ __forceinline__ void mid(f32x4 (&acc)[2][2][4][2], const Unit& u, int wr, int wc, int fr, int fq) const {
        int row0 = u.pm * BM + wr * 64 + fr, col0 = u.pn * BM + wc * 32 + 4 * fq;
        asm volatile("" : "+v"(row0), "+v"(col0));
#pragma unroll
        for (int ai = 0; ai < 2; ++ai)
#pragma unroll
            for (int m = 0; m < 4; ++m) { const bf16_t* pr = proj + (size_t)(row0 + ai * HALF + m * 16) * NINP + col0;
#pragma unroll
                for (int bj = 0; bj < 2; ++bj)
#pragma unroll
                    for (int n = 0; n < 2; ++n) { const u32x2 ga = *(const u32x2*)(pr + C_GA + bj * HALF + n * 16), gb = *(const u32x2*)(pr + C_GB + bj * HALF + n * 16);
                        f32x4 r;
                        r[0] = (1.0f + __expf(-lo_bf(gb.x))) * __builtin_amdgcn_rcpf(1.0f + __expf(-lo_bf(ga.x))); r[1] = (1.0f + __expf(-hi_bf(gb.x))) * __builtin_amdgcn_rcpf(1.0f + __expf(-hi_bf(ga.x)));
                        r[2] = (1.0f + __expf(-lo_bf(gb.y))) * __builtin_amdgcn_rcpf(1.0f + __expf(-lo_bf(ga.y))); r[3] = (1.0f + __expf(-hi_bf(gb.y))) * __builtin_amdgcn_rcpf(1.0f + __expf(-hi_bf(ga.y)));
                        acc[ai][bj][m][n] *= r; } }
        asm volatile("s_waitcnt vmcnt(0)" ::: "memory");
    }
    __device__ __forceinline__ void operator()(const f32x4 (&acc)[2][2][4][2], const Unit& u, int wr, int wc, int fr, int fq) const {
        const int row0 = u.pm * BM + wr * 64 + fr, col0 = u.pn * BM + wc * 32 + 4 * fq;
#pragma unroll
        for (int ai = 0; ai < 2; ++ai)
#pragma unroll
            for (int m = 0; m < 4; ++m) { const int row = row0 + ai * HALF + m * 16; const bf16_t* pr = proj + (size_t)row * NINP + C_GB + col0;
#pragma unroll
                for (int bj = 0; bj < 2; ++bj)
#pragma unroll
                    for (int n = 0; n < 2; ++n) { const u32x2 gb = *(const u32x2*)(pr + bj * HALF + n * 16); const f32x4 v = acc[ai][bj][m][n]; u32x2 w;
                        w.x = cvt_pk_bf16(v[0] * sigmoidf_(lo_bf(gb.x)), v[1] * sigmoidf_(hi_bf(gb.x))); w.y = cvt_pk_bf16(v[2] * sigmoidf_(lo_bf(gb.y)), v[3] * sigmoidf_(hi_bf(gb.y)));
                        *(u32x2*)(merged + (size_t)row * D + col0 + bj * HALF + n * 16) = w; } }
    }
};
template <int WHICH> struct EpiRes { static constexpr bool HAS_MID = false, PERM = false, AFTER_DRAIN = false; const float* xp; const float* ada; bf16_t* xb; float* dst;
    __device__ __forceinline__ void operator()(const f32x4 (&acc)[2][2][4][2], const Unit& u, int wr, int wc, int fr, int fq) const {
        const int row0 = u.pm * BM + wr * 64 + fr, col0 = u.pn * BM + wc * 32 + 4 * fq;
#pragma unroll
        for (int ai = 0; ai < 2; ++ai)
#pragma unroll
            for (int m = 0; m < 4; ++m) { const int row = row0 + ai * HALF + m * 16;
                const float* g = ada + (size_t)(row >> 11) * NADA + (WHICH == 0 ? 2 * D : 5 * D);
#pragma unroll
                for (int bj = 0; bj < 2; ++bj)
#pragma unroll
                    for (int n = 0; n < 2; ++n) { const int col = col0 + bj * HALF + n * 16; const f32x4 gv = *(const f32x4*)(g + col);
                        if (WHICH == 0) { const f32x4 o = __builtin_nontemporal_load((const f32x4*)(xp + (size_t)row * D + col)) * ALPHA + gv * acc[ai][bj][m][n];
                            u32x2 w; w.x = cvt_pk_bf16(o[0], o[1]); w.y = cvt_pk_bf16(o[2], o[3]); *(u32x2*)(xb + (size_t)row * D + col) = w; }
                        else { const u32x2 xw = *(const u32x2*)(xb + (size_t)row * D + col); const f32x4 bv = {lo_bf(xw.x), hi_bf(xw.x), lo_bf(xw.y), hi_bf(xw.y)};
                            *(f32x4*)(dst + (size_t)row * D + col) = bv * ALPHA + gv * acc[ai][bj][m][n]; } } }
    }
};

__device__ __forceinline__ bf16x8 ldfrag(const bf16_t* base, int row, int stride, int k) { return *(const bf16x8*)(base + row * stride + k); }
#define MFMA16(x, y, c) __builtin_amdgcn_mfma_f32_16x16x32_bf16((x), (y), (c), 0, 0, 0)

typedef float f32x2v __attribute__((ext_vector_type(2)));

static __device__ __forceinline__ void ret_prompt_item(const Params& P, int b, int h, unsigned char* smem) {
    const int tid = threadIdx.x, lane = tid & 63, wave = tid >> 6, fr = lane & 15, fq = lane >> 4;
    bf16_t* Qs = (bf16_t*)smem;
    bf16_t* Ks = Qs + 64 * 136;
    bf16_t* Kdt = Ks + 64 * 136;
    bf16_t* Vt = Kdt + 128 * 72;
    bf16_t* Ps = Vt + 128 * 72;
    bf16_t* St = Ps + 64 * 72;
    float* gpow = (float*)(St + 128 * 136);
    const bf16_t* proj = (const bf16_t*)(P.ws + WS_RA);
    const float* cosT = (const float*)(P.ws + WS_ROPE); const float* sinT = cosT + 2049 * 64;
    bf16_t* oret = (bf16_t*)P.out;
    const float log_g = log1pf(-exp2f(-5.0f - (float)h));
    if (tid < 80) gpow[tid] = expf(log_g * (float)tid);
    for (int i = tid; i < 128 * 136 / 2; i += 512) ((unsigned*)St)[i] = 0u;
    f32x4 S[8];
#pragma unroll
    for (int i = 0; i < 8; ++i) S[i] = (f32x4){0.f, 0.f, 0.f, 0.f};
    __syncthreads();
    const int j = tid >> 3, dg = tid & 7;
    u32x4 q1, q2, k1, k2, v1, v2; f32x4 c0, c1, s0, s1;
#define RET_LOAD(c) do { const int pos = (c) * 64 + j; const bf16_t* pr = proj + ((size_t)b * SEQ + pos) * NINP + h * 128; \
        q1 = __builtin_nontemporal_load((const u32x4*)(pr + C_Q + dg * 8)); q2 = __builtin_nontemporal_load((const u32x4*)(pr + C_Q + 64 + dg * 8)); k1 = __builtin_nontemporal_load((const u32x4*)(pr + C_K + dg * 8)); k2 = __builtin_nontemporal_load((const u32x4*)(pr + C_K + 64 + dg * 8)); \
        v1 = __builtin_nontemporal_load((const u32x4*)(pr + C_V + dg * 16)); v2 = __builtin_nontemporal_load((const u32x4*)(pr + C_V + dg * 16 + 8)); \
        c0 = *(const f32x4*)(cosT + pos * 64 + dg * 8); c1 = *(const f32x4*)(cosT + pos * 64 + dg * 8 + 4); s0 = *(const f32x4*)(sinT + pos * 64 + dg * 8); s1 = *(const f32x4*)(sinT + pos * 64 + dg * 8 + 4); } while (0)
    RET_LOAD(0);
    for (int c = 0; c < SEQ / 64; ++c) {
        {
            float cs[8] = {c0[0], c0[1], c0[2], c0[3], c1[0], c1[1], c1[2], c1[3]}, sn[8] = {s0[0], s0[1], s0[2], s0[3], s1[0], s1[1], s1[2], s1[3]};
            const unsigned qa[4] = {q1.x, q1.y, q1.z, q1.w}, qb[4] = {q2.x, q2.y, q2.z, q2.w}, ka[4] = {k1.x, k1.y, k1.z, k1.w}, kb[4] = {k2.x, k2.y, k2.z, k2.w};
            float qo1[8], qo2[8], ko1[8], ko2[8];
#pragma unroll
            for (int e = 0; e < 4; ++e) {
#pragma unroll
                for (int hh = 0; hh < 2; ++hh) { const int i = e * 2 + hh;
                    const float a1 = hh ? hi_bf(qa[e]) : lo_bf(qa[e]), a2 = hh ? hi_bf(qb[e]) : lo_bf(qb[e]);
                    const float b1 = hh ? hi_bf(ka[e]) : lo_bf(ka[e]), b2 = hh ? hi_bf(kb[e]) : lo_bf(kb[e]);
                    qo1[i] = a1 * cs[i] - a2 * sn[i]; qo2[i] = a1 * sn[i] + a2 * cs[i];
                    ko1[i] = (b1 * cs[i] - b2 * sn[i]) * 0.08838834764831845f; ko2[i] = (b1 * sn[i] + b2 * cs[i]) * 0.08838834764831845f; } }
            u32x4 w;
            w.x = cvt_pk_bf16(qo1[0], qo1[1]); w.y = cvt_pk_bf16(qo1[2], qo1[3]); w.z = cvt_pk_bf16(qo1[4], qo1[5]); w.w = cvt_pk_bf16(qo1[6], qo1[7]); *(u32x4*)(Qs + j * 136 + dg * 8) = w;
            w.x = cvt_pk_bf16(qo2[0], qo2[1]); w.y = cvt_pk_bf16(qo2[2], qo2[3]); w.z = cvt_pk_bf16(qo2[4], qo2[5]); w.w = cvt_pk_bf16(qo2[6], qo2[7]); *(u32x4*)(Qs + j * 136 + 64 + dg * 8) = w;
            w.x = cvt_pk_bf16(ko1[0], ko1[1]); w.y = cvt_pk_bf16(ko1[2], ko1[3]); w.z = cvt_pk_bf16(ko1[4], ko1[5]); w.w = cvt_pk_bf16(ko1[6], ko1[7]); *(u32x4*)(Ks + j * 136 + dg * 8) = w;
            w.x = cvt_pk_bf16(ko2[0], ko2[1]); w.y = cvt_pk_bf16(ko2[2], ko2[3]); w.z = cvt_pk_bf16(ko2[4], ko2[5]); w.w = cvt_pk_bf16(ko2[6], ko2[7]); *(u32x4*)(Ks + j * 136 + 64 + dg * 8) = w;
            const float kd = gpow[63 - j];
#pragma unroll
            for (int i = 0; i < 8; ++i) { Kdt[(dg * 8 + i) * 72 + j] = f2bf(ko1[i] * kd); Kdt[(64 + dg * 8 + i) * 72 + j] = f2bf(ko2[i] * kd); }
            const unsigned va[8] = {v1.x, v1.y, v1.z, v1.w, v2.x, v2.y, v2.z, v2.w};
#pragma unroll
            for (int e = 0; e < 8; ++e) { Vt[(dg * 16 + 2 * e) * 72 + j] = (bf16_t)(va[e] & 0xffffu); Vt[(dg * 16 + 2 * e + 1) * 72 + j] = (bf16_t)(va[e] >> 16); }
        }
        RW_BAR();
        if (c + 1 < SEQ / 64) RET_LOAD(c + 1);
        f32x4 O[4];
#pragma unroll
        for (int it = 0; it < 4; ++it) O[it] = (f32x4){0.f, 0.f, 0.f, 0.f};
#pragma unroll
        for (int ks = 0; ks < 4; ++ks) { const bf16x8 yf = ldfrag(St, wave * 16 + fr, 136, ks * 32 + fq * 8);
#pragma unroll
            for (int it = 0; it < 4; ++it) O[it] = MFMA16(ldfrag(Qs, it * 16 + fr, 136, ks * 32 + fq * 8), yf, O[it]); }
#pragma unroll
        for (int it = 0; it < 4; ++it)
#pragma unroll
            for (int jj = 0; jj < 4; ++jj) O[it][jj] *= gpow[it * 16 + fq * 4 + jj + 1];
        { const int it = wave >> 1;
#pragma unroll
            for (int j2 = 0; j2 < 2; ++j2) { const int jt = (wave & 1) * 2 + j2; f32x4 a = (f32x4){0.f, 0.f, 0.f, 0.f};
#pragma unroll
                for (int ks = 0; ks < 4; ++ks) a = MFMA16(ldfrag(Qs, it * 16 + fr, 136, ks * 32 + fq * 8), ldfrag(Ks, jt * 16 + fr, 136, ks * 32 + fq * 8), a);
#pragma unroll
                for (int jj = 0; jj < 4; ++jj) { const int i = it * 16 + fq * 4 + jj, jc = jt * 16 + fr; const int dd = i - jc;
                    const float pv = dd >= 0 ? a[jj] * gpow[dd >= 0 ? dd : 0] : 0.f; Ps[i * 72 + jc] = f2bf(pv); } } }
        RW_BAR();
#pragma unroll
        for (int ks = 0; ks < 2; ++ks) { const bf16x8 yf = ldfrag(Vt, wave * 16 + fr, 72, ks * 32 + fq * 8);
#pragma unroll
            for (int it = 0; it < 4; ++it) O[it] = MFMA16(ldfrag(Ps, it * 16 + fr, 72, ks * 32 + fq * 8), yf, O[it]); }
#pragma unroll
        for (int it = 0; it < 4; ++it)
#pragma unroll
            for (int jj = 0; jj < 4; ++jj) { const int i = it * 16 + fq * 4 + jj; oret[((size_t)b * SEQ + c * 64 + i) * RW + h * 128 + wave * 16 + fr] = f2bf(O[it][jj]); }
        { const float bd = gpow[64];
#pragma unroll
            for (int dt = 0; dt < 8; ++dt) S[dt] *= bd;
#pragma unroll
            for (int ks = 0; ks < 2; ++ks) { const bf16x8 yf = ldfrag(Vt, wave * 16 + fr, 72, ks * 32 + fq * 8);
#pragma unroll
                for (int dt = 0; dt < 8; ++dt) S[dt] = MFMA16(ldfrag(Kdt, dt * 16 + fr, 72, ks * 32 + fq * 8), yf, S[dt]); } }
        RW_BAR();
#pragma unroll
        for (int dt = 0; dt < 8; ++dt) { u32x2 w; w.x = cvt_pk_bf16(S[dt][0], S[dt][1]); w.y = cvt_pk_bf16(S[dt][2], S[dt][3]); *(u32x2*)(St + (wave * 16 + fr) * 136 + dt * 16 + fq * 4) = w; }
    }
    float* so = P.out + O_RETP + (size_t)(b * 8 + h) * 128 * 128;
#pragma unroll
    for (int dt = 0; dt < 8; ++dt)
#pragma unroll
        for (int jj = 0; jj < 4; ++jj) so[(dt * 16 + fq * 4 + jj) * 128 + wave * 16 + fr] = S[dt][jj];
    __syncthreads();
}

static __device__ __forceinline__ void ret_sample_pair(const Params& P, int pair, unsigned char* smem) {
    const int tid = threadIdx.x, lane = tid & 63;
    float* qs = (float*)smem; float* ks = qs + 128; float* red = ks + 128;
    const int i = pair >> 3, h = pair & 7; const size_t row = (size_t)MPR + i;
    const bf16_t* pr = (const bf16_t*)(P.ws + WS_RA) + row * NINP + h * 128;
    const float* cosT = (const float*)(P.ws + WS_ROPE) + 2048 * 64; const float* sinT = cosT + 2049 * 64;
    const int c4 = (tid & 31) * 4, g = tid >> 5;
    const float* S0 = P.in[I_SRET] + (size_t)pair * 128 * 128 + (size_t)(g * 8) * 128 + c4; float* So = P.out + O_RETS + (size_t)pair * 128 * 128 + (size_t)(g * 8) * 128 + c4;
    f32x4 sv[8];
#pragma unroll
    for (int e = 0; e < 8; ++e) sv[e] = __builtin_nontemporal_load((const f32x4*)(S0 + e * 128));
    const u32x2 vw = *(const u32x2*)(pr + C_V + c4); const f32x4 vv = {lo_bf(vw.x), hi_bf(vw.x), lo_bf(vw.y), hi_bf(vw.y)};
    if (tid < 64) { const float cc = cosT[tid], ss = sinT[tid];
        const float a1 = bf2f(pr[C_Q + tid]), a2 = bf2f(pr[C_Q + 64 + tid]), b1 = bf2f(pr[C_K + tid]), b2 = bf2f(pr[C_K + 64 + tid]);
        qs[tid] = a1 * cc - a2 * ss; qs[64 + tid] = a1 * ss + a2 * cc;
        ks[tid] = (b1 * cc - b2 * ss) * 0.08838834764831845f; ks[64 + tid] = (b1 * ss + b2 * cc) * 0.08838834764831845f; }
    __syncthreads();
    const float qk = wave_sum(qs[lane] * ks[lane] + qs[64 + lane] * ks[64 + lane]);
    const float gam = 1.0f - exp2f(-5.0f - (float)h);
    f32x4 acc = {0.f, 0.f, 0.f, 0.f};
#pragma unroll
    for (int e = 0; e < 8; ++e) { const float q = qs[g * 8 + e], k = ks[g * 8 + e]; acc += sv[e] * q; __builtin_nontemporal_store(sv[e] * gam + vv * k, (f32x4*)(So + e * 128)); }
    *(f32x4*)(red + g * 128 + c4) = acc;
    __syncthreads();
    if (tid < 128) { float t = 0.f;
#pragma unroll
        for (int e = 0; e < 16; ++e) t += red[e * 128 + tid];
        ((bf16_t*)P.out)[row * RW + h * 128 + tid] = f2bf(qk * bf2f(pr[C_V + tid]) + gam * t); }
    __syncthreads();
}

__device__ __forceinline__ float fma_s(float a, float b, float c) { float d; asm("v_fma_f32 %0, %1, %2, %3" : "=v"(d) : "v"(a), "v"(b), "v"(c)); return d; }
__device__ __forceinline__ float fnma_s(float a, float b, float c) { float d; asm("v_fma_f32 %0, -%1, %2, %3" : "=v"(d) : "v"(a), "v"(b), "v"(c)); return d; }
__device__ __forceinline__ float mul_s(float a, float b) { float d; asm("v_mul_f32 %0, %1, %2" : "=v"(d) : "v"(a), "v"(b)); return d; }
static __device__ __forceinline__ void rwkv_prompt_item(const Params& P, int item, unsigned char* smem) {
    const int tid = threadIdx.x, lane = tid & 63, wave = tid >> 6;
    const int bh = item >> 1, half = item & 1, b = bh >> 4, h = bh & 15;
    float* BUF = (float*)smem;
    float* OOb = BUF + 2 * 12288;
    const bf16_t* proj = (const bf16_t*)(P.ws + WS_RA);
    const float* decA = (const float*)(P.ws + WS_RB); const float* aaA = decA + (size_t)MP * RW;
    bf16_t* oraw = (bf16_t*)(P.ws + WS_RC); float* bonus = (float*)(P.ws + WS_BONUS);
    const int col = h * 64 + lane;
    const size_t rowb = (size_t)b * SEQ;
    constexpr int NCH = SEQ / 32;
    if (wave >= 4) {
        const int pw = wave - 4, ptid = tid - 256;
        const float mu_r = P.in[I_MU][col], mu_k = P.in[I_MU][RW + col], mu_v = P.in[I_MU][2 * RW + col];
        const float kk_c = P.in[I_KK][col], ka_c = P.in[I_KA][col], rk_c = P.in[I_RK][col];
        float zr[9], zk[9], zv[9], av[8], dcv[8];
#define RWKV_LOAD(c) do { const int t0 = (c) * 32 + pw * 8; \
        _Pragma("unroll") for (int e = 0; e < 9; ++e) { const int t = t0 + e - 1; \
            if (t >= 0) { const bf16_t* pz = proj + (rowb + t) * NINP + col; zr[e] = bf2f(pz[0]); zk[e] = bf2f(pz[RW]); zv[e] = bf2f(pz[2 * RW]); } else { zr[e] = 0.f; zk[e] = 0.f; zv[e] = 0.f; } } \
        _Pragma("unroll") for (int e = 0; e < 8; ++e) { av[e] = aaA[(rowb + t0 + e) * RW + col]; dcv[e] = decA[(rowb + t0 + e) * RW + col]; } } while (0)
#define RWKV_STAGE(c) do { float* kb = BUF + ((c) & 1) * 12288; \
        _Pragma("unroll") for (int e = 0; e < 8; ++e) { const int tt = pw * 8 + e; \
            const float r = zr[e + 1] + mu_r * (zr[e] - zr[e + 1]), k = zk[e + 1] + mu_k * (zk[e] - zk[e + 1]), v = zv[e + 1] + mu_v * (zv[e] - zv[e + 1]); \
            const float kkv = k * kk_c; const float nrm = sqrtf(wave_sum(kkv * kkv)); const float kkn = kkv / fmaxf(nrm, 1e-12f); \
            const float a = av[e]; const float kx = k * (1.0f + (a - 1.0f) * ka_c); \
            const float bo = wave_sum(r * kx * rk_c); \
            kb[tt * 64 + lane] = kkn; kb[2048 + tt * 64 + lane] = dcv[e]; kb[4096 + tt * 64 + lane] = kkn * a; kb[6144 + tt * 64 + lane] = kx; kb[8192 + tt * 64 + lane] = r; kb[10240 + tt * 64 + lane] = v; \
            if (half == 0 && lane == 0) bonus[(rowb + (c) * 32 + tt) * 16 + h] = bo; } } while (0)
#define RWKV_OWRITE(c) do { const float* oo = OOb + ((c) & 1) * 1024; \
        _Pragma("unroll") for (int k2 = 0; k2 < 4; ++k2) { const int idx = ptid + k2 * 256, tt = idx >> 5, i = idx & 31; oraw[(rowb + (c) * 32 + tt) * RW + h * 64 + half * 32 + i] = f2bf(oo[idx]); } } while (0)
        RWKV_LOAD(0); RWKV_STAGE(0); RWKV_LOAD(1);
        RW_BAR();
        for (int c = 0; c < NCH; ++c) {
            if (c + 1 < NCH) { RWKV_STAGE(c + 1); if (c + 2 < NCH) RWKV_LOAD(c + 2); }
            if (c >= 1) RWKV_OWRITE(c - 1);
            RW_BAR();
        }
        RWKV_OWRITE(NCH - 1);
#undef RWKV_LOAD
#undef RWKV_STAGE
#undef RWKV_OWRITE
    } else {
        const int rr = lane >> 3, s = lane & 7, r32 = wave * 8 + rr;
        f32x2v S01 = {0.f, 0.f}, S23 = {0.f, 0.f}, S45 = {0.f, 0.f}, S67 = {0.f, 0.f};
        RW_BAR();
        for (int c = 0; c < NCH; ++c) {
            const float* kb = BUF + (c & 1) * 12288 + s * 8;
            const float* vb = BUF + (c & 1) * 12288 + 10240 + half * 32 + r32;
            float ok0 = 0.f, ok1 = 0.f, ok2 = 0.f, ok3 = 0.f, qprev = 0.f;
            f32x4 kka = *(const f32x4*)(kb), kkb = *(const f32x4*)(kb + 4), wa = *(const f32x4*)(kb + 2048), wb = *(const f32x4*)(kb + 2052), ba = *(const f32x4*)(kb + 4096), bb_ = *(const f32x4*)(kb + 4100);
            f32x4 kxa = *(const f32x4*)(kb + 6144), kxb = *(const f32x4*)(kb + 6148), ra = *(const f32x4*)(kb + 8192), rb = *(const f32x4*)(kb + 8196); float vn = vb[0];
#pragma unroll
            for (int tt = 0; tt < 32; ++tt) {
                const f32x4 k0 = kka, k1 = kkb, w0 = wa, w1 = wb, b0 = ba, b1 = bb_, x0 = kxa, x1 = kxb, r0 = ra, r1 = rb; const float vA = vn;
                if (tt + 1 < 32) { const float* kq = kb + (tt + 1) * 64; kka = *(const f32x4*)(kq); kkb = *(const f32x4*)(kq + 4); wa = *(const f32x4*)(kq + 2048); wb = *(const f32x4*)(kq + 2052); ba = *(const f32x4*)(kq + 4096); bb_ = *(const f32x4*)(kq + 4100);
                    kxa = *(const f32x4*)(kq + 6144); kxb = *(const f32x4*)(kq + 6148); ra = *(const f32x4*)(kq + 8192); rb = *(const f32x4*)(kq + 8196); vn = vb[(tt + 1) * 64]; }
                __builtin_amdgcn_sched_barrier(0);
                f32x2v pp = S01 * (f32x2v){k0[0], k0[1]}; pp = S23 * (f32x2v){k0[2], k0[3]} + pp; pp = S45 * (f32x2v){k1[0], k1[1]} + pp; pp = S67 * (f32x2v){k1[2], k1[3]} + pp;
                float p = pp.x + pp.y;
                f32x2v u01 = (f32x2v){x0[0], x0[1]} * vA, u23 = (f32x2v){x0[2], x0[3]} * vA, u45 = (f32x2v){x1[0], x1[1]} * vA, u67 = (f32x2v){x1[2], x1[3]} * vA;
                if (tt > 0) {
                    float q = qprev; q += dpp_f<0xB1>(q); q += dpp_f<0x4E>(q); q += dpp_f<0x141>(q);
                    const int tp = tt - 1;
                    if (s == (tp & 7)) { if ((tp >> 3) == 0) ok0 = q; else if ((tp >> 3) == 1) ok1 = q; else if ((tp >> 3) == 2) ok2 = q; else ok3 = q; } }
                p += dpp_f<0xB1>(p); p += dpp_f<0x4E>(p); p += dpp_f<0x141>(p);
                u01 = u01 - (f32x2v){b0[0], b0[1]} * p; u23 = u23 - (f32x2v){b0[2], b0[3]} * p; u45 = u45 - (f32x2v){b1[0], b1[1]} * p; u67 = u67 - (f32x2v){b1[2], b1[3]} * p;
                S01 = S01 * (f32x2v){w0[0], w0[1]} + u01; S23 = S23 * (f32x2v){w0[2], w0[3]} + u23; S45 = S45 * (f32x2v){w1[0], w1[1]} + u45; S67 = S67 * (f32x2v){w1[2], w1[3]} + u67;
                f32x2v qq = S01 * (f32x2v){r0[0], r0[1]}; qq = S23 * (f32x2v){r0[2], r0[3]} + qq; qq = S45 * (f32x2v){r1[0], r1[1]} + qq; qq = S67 * (f32x2v){r1[2], r1[3]} + qq;
                qprev = qq.x + qq.y;
            }
            { float q = qprev; q += dpp_f<0xB1>(q); q += dpp_f<0x4E>(q); q += dpp_f<0x141>(q); if (s == 7) ok3 = q; }
            float* oo = OOb + (c & 1) * 1024;
            oo[s * 32 + r32] = ok0; oo[(8 + s) * 32 + r32] = ok1; oo[(16 + s) * 32 + r32] = ok2; oo[(24 + s) * 32 + r32] = ok3;
            RW_BAR();
        }
        float* so = P.out + O_WKVP + ((size_t)(b * 16 + h) * 64 + half * 32 + r32) * 64 + s * 8;
        { f32x4 o = {S01.x, S01.y, S23.x, S23.y}; *(f32x4*)(so) = o; }
        { f32x4 o = {S45.x, S45.y, S67.x, S67.y}; *(f32x4*)(so + 4) = o; }
    }
    __syncthreads();
}

static __device__ __forceinline__ void rwkv_sample_pair(const Params& P, int pair) {
    const int lane = threadIdx.x & 63; const int i = pair >> 4, h = pair & 15; const size_t row = (size_t)MPR + i; const int col = h * 64 + lane;
    const bf16_t* pz = (const bf16_t*)(P.ws + WS_RA) + row * NINP + col;
    const float* sp = P.in[I_SSHIFT] + (size_t)i * PRW + col;
    const float zr = bf2f(pz[0]), zk = bf2f(pz[RW]), zv = bf2f(pz[2 * RW]);
    const float r = zr + P.in[I_MU][col] * (sp[0] - zr), k = zk + P.in[I_MU][RW + col] * (sp[RW] - zk), v = zv + P.in[I_MU][2 * RW + col] * (sp[2 * RW] - zv);
    const float* decA = (const float*)(P.ws + WS_RB); const float* aaA = decA + (size_t)MP * RW;
    const float a = aaA[row * RW + col], dec = decA[row * RW + col];
    const float kkv = k * P.in[I_KK][col]; const float nrm = sqrtf(wave_sum(kkv * kkv)); const float kkn = kkv / fmaxf(nrm, 1e-12f);
    const float kx = k * (1.0f + (a - 1.0f) * P.in[I_KA][col]); const float bb = kkn * a;
    const float bo = wave_sum(r * kx * P.in[I_RK][col]);
    if (lane == 0) ((float*)(P.ws + WS_BONUS))[row * 16 + h] = bo;
    const float* S0 = P.in[I_SWKV] + (size_t)pair * 4096; float* So = P.out + O_WKVS + (size_t)pair * 4096;
    float omine = 0.f;
#pragma unroll 1
    for (int vb = 0; vb < 64; vb += 16) { float svv[16];
#pragma unroll
    for (int e = 0; e < 16; ++e) svv[e] = __builtin_nontemporal_load(S0 + (vb + e) * 64 + lane);
#pragma unroll
    for (int e = 0; e < 16; ++e) { const int vr = vb + e; const float sv = svv[e]; const float sa = -wave_sum(sv * kkn); const float vv = __shfl(v, vr);
        const float sn = sv * dec + sa * bb + vv * kx; __builtin_nontemporal_store(sn, So + vr * 64 + lane); const float o = wave_sum(sn * r); if (lane == vr) omine = o; } }
    ((bf16_t*)(P.ws + WS_RC))[row * RW + col] = f2bf(omine);
}

__device__ __forceinline__ void unpack8(const u32x4 t, float (&o)[8]) { o[0] = lo_bf(t.x); o[1] = hi_bf(t.x); o[2] = lo_bf(t.y); o[3] = hi_bf(t.y); o[4] = lo_bf(t.z); o[5] = hi_bf(t.z); o[6] = lo_bf(t.w); o[7] = hi_bf(t.w); }
static __device__ __forceinline__ void phase_misc0(const Params& P) {
    const size_t gtid = (size_t)blockIdx.x * 512 + threadIdx.x, gsz = (size_t)gridDim.x * 512;
    bf16_t* aada = (bf16_t*)(P.ws + WS_AADA);
    for (size_t i = gtid; i < (size_t)256 * D; i += gsz) { const int r = (int)(i / D), c = (int)(i % D);
        const float v = r < NB ? P.in[I_CP][r * D + c] : (r < NB + NS ? P.in[I_CS][(r - NB) * D + c] : 0.f); aada[i] = f2bf(v); }
    float* cosT = (float*)(P.ws + WS_ROPE); float* sinT = cosT + 2049 * 64;
    for (size_t i = gtid; i < (size_t)2049 * 64; i += gsz) { const int pi = (int)(i >> 6), jx = (int)(i & 63);
        const double pos = pi == 2048 ? 16384.0 : (double)pi;
        const float inv = (float)exp(-((double)jx / 64.0) * 9.210340371976184);
        const double ang = pos * (double)inv;
        const double n = rint(ang * 0.15915494309189535); const double rr = ang - n * 6.283185307179586;
        const double r2 = rr * rr; double ts = rr, tc = 1.0, sv = rr, cv = 1.0;
#pragma unroll 1
        for (int k = 1; k <= 13; ++k) { tc *= -r2 / (double)((2 * k - 1) * (2 * k)); ts *= -r2 / (double)((2 * k) * (2 * k + 1)); cv += tc; sv += ts; }
        cosT[i] = (float)cv; sinT[i] = (float)sv; }
}
static __device__ __forceinline__ void phase_misc1(const Params& P, size_t gtid, size_t gsz) {
    unsigned* z = (unsigned*)((bf16_t*)(P.ws + WS_WIN) + (size_t)PRW * D);
    for (size_t i = gtid; i < (size_t)(C_Q - PRW) * D / 2; i += gsz) z[i] = 0u;
    bf16_t* bl = (bf16_t*)(P.ws + WS_WLORA);
    for (size_t i = gtid; i < (size_t)NL * KL; i += gsz) { const int n = (int)(i / KL), k = (int)(i % KL); float v = 0.f;
        if (n < 1024) { if (k < 64) v = P.in[I_WDEC][k * RW + n]; }
        else if (n < 2048) { if (k >= 64 && k < 128) v = P.in[I_WAAA][(k - 64) * RW + (n - 1024)]; }
        else { if (k >= 128 && k < 288) v = P.in[I_WGATE][(k - 128) * RW + (n - 2048)]; }
        bl[i] = f2bf(v); }
}
static __device__ __forceinline__ void phase_modulate(const Params& P) {
    const float* ada = (const float*)(P.ws + WS_ADA); bf16_t* u = (bf16_t*)(P.ws + WS_RC);
    for (size_t i = (size_t)blockIdx.x * 512 + threadIdx.x; i < (size_t)MP * (D / 8); i += (size_t)gridDim.x * 512) {
        const int row = (int)(i >> 8), c = (int)(i & 255) * 8; u32x4 w = {0u, 0u, 0u, 0u};
        if (row < MTOK) { const float* x = row < MPR ? P.in[I_XP] + (size_t)row * D : P.in[I_XS] + (size_t)(row - MPR) * D; const float* ar = ada + (size_t)ada_row(row) * NADA;
            const f32x4 x0 = __builtin_nontemporal_load((const f32x4*)(x + c)), x1 = __builtin_nontemporal_load((const f32x4*)(x + c + 4)), h0 = *(const f32x4*)(ar + c), h1 = *(const f32x4*)(ar + c + 4), s0 = *(const f32x4*)(ar + D + c), s1 = *(const f32x4*)(ar + D + c + 4);
            const f32x4 a = x0 * (s0 + 1.0f) + h0, b = x1 * (s1 + 1.0f) + h1;
            w.x = cvt_pk_bf16(a[0], a[1]); w.y = cvt_pk_bf16(a[2], a[3]); w.z = cvt_pk_bf16(b[0], b[1]); w.w = cvt_pk_bf16(b[2], b[3]); }
        *(u32x4*)(u + (size_t)row * D + c) = w; }
}
static __device__ __forceinline__ void phase_lora_in(const Params& P) {
    const bf16_t* proj = (const bf16_t*)(P.ws + WS_RA); bf16_t* al = (bf16_t*)(P.ws + WS_ALORA);
    const size_t gtid = (size_t)blockIdx.x * 512 + threadIdx.x, gsz = (size_t)gridDim.x * 512;
    for (size_t i = gtid; i < (size_t)MP * (KL / 8); i += gsz) { const int row = (int)(i / (KL / 8)), k = (int)(i % (KL / 8)) * 8; u32x4 w = {0u, 0u, 0u, 0u};
        if (row < MTOK && k < 288) { const int c = 3072 + k; float z[8], pv[8], o[8];
            unpack8(*(const u32x4*)(proj + (size_t)row * NINP + c), z);
            if (row < MPR) { u32x4 t1 = {0u, 0u, 0u, 0u}; if ((row & (SEQ - 1)) != 0) t1 = *(const u32x4*)(proj + (size_t)(row - 1) * NINP + c); unpack8(t1, pv); }
            else { const float* sp = P.in[I_SSHIFT] + (size_t)(row - MPR) * PRW + c;
#pragma unroll
                for (int e = 0; e < 8; ++e) pv[e] = sp[e]; }
#pragma unroll
            for (int e = 0; e < 8; ++e) { const float zs = z[e] + P.in[I_MU][c + e] * (pv[e] - z[e]); o[e] = k < 64 ? tanhf(zs) : (k < 128 ? zs : sigmoidf_(zs)); }
            w.x = cvt_pk_bf16(o[0], o[1]); w.y = cvt_pk_bf16(o[2], o[3]); w.z = cvt_pk_bf16(o[4], o[5]); w.w = cvt_pk_bf16(o[6], o[7]); }
        *(u32x4*)(al + (size_t)row * KL + k) = w; }
    for (size_t i = gtid; i < (size_t)(NB + NS) * PRW; i += gsz) { const int r = (int)(i / PRW), c = (int)(i % PRW);
        const size_t row = r < NB ? (size_t)r * SEQ + SEQ - 1 : (size_t)MPR + (r - NB);
        const float v = bf2f(proj[row * NINP + c]);
        if (r < NB) P.out[O_SHIFTP + (size_t)r * PRW + c] = v; else P.out[O_SHIFTS + (size_t)(r - NB) * PRW + c] = v; }
}
static __device__ __forceinline__ void phase_post(const Params& P) {
    const int lane = threadIdx.x & 63, wave = threadIdx.x >> 6;
    const bf16_t* __restrict__ proj = (const bf16_t*)(P.ws + WS_RA); const bf16_t* __restrict__ oraw = (const bf16_t*)(P.ws + WS_RC); const bf16_t* __restrict__ oret = (const bf16_t*)P.out;
    const float* __restrict__ bonus = (const float*)(P.ws + WS_BONUS); const bf16_t* __restrict__ gg = (const bf16_t*)(P.ws + WS_RB + (size_t)2 * MP * RW * 4);
    bf16_t* __restrict__ ya = (bf16_t*)(P.ws + WS_RD); bf16_t* __restrict__ yb = ya + RW;
    const int ca0 = (wave * 2) * 64 + lane, ca1 = ca0 + 64, cb0 = wave * 128 + lane, cb1 = cb0 + 64;
    const float lw0 = P.in[I_LNXW][ca0], lw1 = P.in[I_LNXW][ca1], lb0 = P.in[I_LNXB][ca0], lb1 = P.in[I_LNXB][ca1], mv0 = P.in[I_MU][2 * RW + ca0], mv1 = P.in[I_MU][2 * RW + ca1];
    const float gw0 = P.in[I_RGNW][cb0], gw1 = P.in[I_RGNW][cb1], gb0 = P.in[I_RGNB][cb0], gb1 = P.in[I_RGNB][cb1];
    for (int row0 = blockIdx.x * 8; row0 < MP; row0 += gridDim.x * 8) {
        if (row0 >= MTOK) { for (int i = threadIdx.x; i < 8 * D; i += 512) ya[(size_t)row0 * D + i] = 0; continue; }
        float o0[8], o1[8], z0[8], z1[8], p0[8], p1[8], bn0[8], bn1[8], g0[8], g1[8], r0[8], r1[8], q0[8], q1[8];
#pragma unroll
        for (int e = 0; e < 8; ++e) { const size_t row = (size_t)row0 + e;
            o0[e] = bf2f(__builtin_nontemporal_load(oraw + row * RW + ca0)); o1[e] = bf2f(__builtin_nontemporal_load(oraw + row * RW + ca1));
            z0[e] = bf2f(proj[row * NINP + 2 * RW + ca0]); z1[e] = bf2f(proj[row * NINP + 2 * RW + ca1]);
            if (row < MPR) { const bool first = (row & (SEQ - 1)) == 0; p0[e] = first ? 0.f : bf2f(proj[(row - 1) * NINP + 2 * RW + ca0]); p1[e] = first ? 0.f : bf2f(proj[(row - 1) * NINP + 2 * RW + ca1]); }
            else { p0[e] = P.in[I_SSHIFT][(row - MPR) * PRW + 2 * RW + ca0]; p1[e] = P.in[I_SSHIFT][(row - MPR) * PRW + 2 * RW + ca1]; }
            bn0[e] = bonus[row * 16 + wave * 2]; bn1[e] = bonus[row * 16 + wave * 2 + 1];
            g0[e] = bf2f(gg[row * RW + ca0]); g1[e] = bf2f(gg[row * RW + ca1]);
            r0[e] = bf2f(__builtin_nontemporal_load(oret + row * RW + cb0)); r1[e] = bf2f(__builtin_nontemporal_load(oret + row * RW + cb1));
            q0[e] = bf2f(proj[row * NINP + C_RG + cb0]); q1[e] = bf2f(proj[row * NINP + C_RG + cb1]); }
#pragma unroll
        for (int e = 0; e < 8; ++e) { const size_t row = (size_t)row0 + e;
            { const float mean = wave_sum(o0[e]) * (1.0f / 64.0f); const float d = o0[e] - mean; const float var = wave_sum(d * d) * (1.0f / 64.0f);
              const float v = z0[e] + mv0 * (p0[e] - z0[e]); const float y = (d * rsqrtf(var + 64e-5f) * lw0 + lb0 + bn0[e] * v) * g0[e]; ya[row * D + ca0] = f2bf(y); }
            { const float mean = wave_sum(o1[e]) * (1.0f / 64.0f); const float d = o1[e] - mean; const float var = wave_sum(d * d) * (1.0f / 64.0f);
              const float v = z1[e] + mv1 * (p1[e] - z1[e]); const float y = (d * rsqrtf(var + 64e-5f) * lw1 + lb1 + bn1[e] * v) * g1[e]; ya[row * D + ca1] = f2bf(y); }
            { const float mean = wave_sum(r0[e] + r1[e]) * (1.0f / 128.0f); const float d0 = r0[e] - mean, d1 = r1[e] - mean; const float var = wave_sum(d0 * d0 + d1 * d1) * (1.0f / 128.0f); const float rs = rsqrtf(var + 1e-5f);
              yb[row * D + cb0] = f2bf((d0 * rs * gw0 + gb0) * (q0[e] * sigmoidf_(q0[e]))); yb[row * D + cb1] = f2bf((d1 * rs * gw1 + gb1) * (q1[e] * sigmoidf_(q1[e]))); } }
    }
}
template <int WHICH> static __device__ __forceinline__ void phase_ln(const Params& P) {
    const int lane = threadIdx.x & 63, wave = threadIdx.x >> 6;
    const float* lw = P.in[WHICH == 0 ? I_LN1W : I_LN2W]; const float* lb = P.in[WHICH == 0 ? I_LN1B : I_LN2B];
    const float* ada = (const float*)(P.ws + WS_ADA); bf16_t* u2 = (bf16_t*)(P.ws + WS_RC); bf16_t* xb = (bf16_t*)(P.ws + WS_RD);
    for (int row = blockIdx.x * 8 + wave; row < (WHICH == 0 ? MP : MTOK); row += gridDim.x * 8) {
        if (row >= MTOK) {
#pragma unroll
            for (int j = 0; j < 8; ++j) { u32x2 z = {0u, 0u}; *(u32x2*)(u2 + (size_t)row * D + j * 256 + lane * 4) = z; }
            continue; }
        float* xr = P.out + (size_t)row * D; bf16_t* xbr = xb + (size_t)row * D; f32x4 v[8]; float sm = 0.f;
        const float* ar = ada + (size_t)ada_row(row) * NADA;
        if (row < MPR) {
#pragma unroll
            for (int j = 0; j < 8; ++j) { const int c = j * 256 + lane * 4;
                if (WHICH == 0) { const u32x2 xw = __builtin_nontemporal_load((const u32x2*)(xbr + c)); v[j] = (f32x4){lo_bf(xw.x), hi_bf(xw.x), lo_bf(xw.y), hi_bf(xw.y)}; }
                else v[j] = __builtin_nontemporal_load((const f32x4*)(xr + c)); }
        } else {
            const float* ab = (const float*)(P.ws + WS_ACC) + (size_t)(WHICH == 0 ? 2 : 3) * NS * D + (size_t)(row - MPR) * D; const float* gt = ar + (WHICH == 0 ? 2 * D : 5 * D);
#pragma unroll
            for (int j = 0; j < 8; ++j) { const int c = j * 256 + lane * 4; f32x4 bv;
                if (WHICH == 0) bv = *(const f32x4*)(P.in[I_XS] + (size_t)(row - MPR) * D + c);
                else bv = *(const f32x4*)(xr + c);
                v[j] = bv * ALPHA + *(const f32x4*)(gt + c) * *(const f32x4*)(ab + c); }
        }
#pragma unroll
        for (int j = 0; j < 8; ++j) sm += (v[j][0] + v[j][1]) + (v[j][2] + v[j][3]);
        const float mean = wave_sum(sm) * (1.0f / D); float q = 0.f;
#pragma unroll
        for (int j = 0; j < 8; ++j) { v[j] = v[j] - mean; q += (v[j][0] * v[j][0] + v[j][1] * v[j][1]) + (v[j][2] * v[j][2] + v[j][3] * v[j][3]); }
        const float rs = rsqrtf(wave_sum(q) * (1.0f / D) + 1e-5f);
#pragma unroll
        for (int j = 0; j < 8; ++j) { const int c = j * 256 + lane * 4; const f32x4 y = v[j] * rs * *(const f32x4*)(lw + c) + *(const f32x4*)(lb + c);
            if (WHICH == 0) { u32x2 w1; w1.x = cvt_pk_bf16(y[0], y[1]); w1.y = cvt_pk_bf16(y[2], y[3]); *(u32x2*)(xbr + c) = w1;
                if (row >= MPR) *(f32x4*)(xr + c) = y;
                const f32x4 o = y * (*(const f32x4*)(ar + 4 * D + c) + 1.0f) + *(const f32x4*)(ar + 3 * D + c);
                u32x2 w; w.x = cvt_pk_bf16(o[0], o[1]); w.y = cvt_pk_bf16(o[2], o[3]); *(u32x2*)(u2 + (size_t)row * D + c) = w; }
            else __builtin_nontemporal_store(y, (f32x4*)(xr + c)); }
    }
}
static __device__ __forceinline__ void phase_conv(const Params& P) {
    const bf16_t* __restrict__ hb = (const bf16_t*)(P.ws + WS_RA); bf16_t* __restrict__ g = (bf16_t*)(P.ws + WS_RB);
    const float* __restrict__ cw = P.in[I_CONVW]; const float* __restrict__ cb = P.in[I_CONVB]; const float* __restrict__ sc = P.in[I_SCONV];
    const size_t gtid = (size_t)blockIdx.x * 512 + threadIdx.x, gsz = (size_t)gridDim.x * 512;
    constexpr int RCH = 16, NCG = DFF / 8;
    for (size_t it = gtid; it < (size_t)(MPR / RCH) * NCG; it += gsz) { const int strip = (int)(it / NCG), c = (int)(it % NCG) * 8; const int row0 = strip * RCH, t0 = row0 & (SEQ - 1);
        float w0[2][8], w1[2][8], w2[2][8], bs[2][8], h1[2][8], h2[2][8];
#pragma unroll
        for (int hf = 0; hf < 2; ++hf) { const int cc = c + hf * DFF;
#pragma unroll
            for (int e = 0; e < 8; e += 4) { const f32x4 a = *(const f32x4*)(cw + cc + e), b2 = *(const f32x4*)(cw + F2 + cc + e), d = *(const f32x4*)(cw + 2 * F2 + cc + e), bb = *(const f32x4*)(cb + cc + e);
#pragma unroll
                for (int j = 0; j < 4; ++j) { w0[hf][e + j] = a[j]; w1[hf][e + j] = b2[j]; w2[hf][e + j] = d[j]; bs[hf][e + j] = bb[j]; } }
            u32x4 t1 = {0u, 0u, 0u, 0u}, t2 = {0u, 0u, 0u, 0u};
            if (t0 >= 1) t1 = *(const u32x4*)(hb + (size_t)(row0 - 1) * F2 + cc);
            if (t0 >= 2) t2 = *(const u32x4*)(hb + (size_t)(row0 - 2) * F2 + cc);
            unpack8(t1, h1[hf]); unpack8(t2, h2[hf]); }
#pragma unroll 4
        for (int r = 0; r < RCH; ++r) { const size_t row = (size_t)row0 + r; float y[2][8];
#pragma unroll
            for (int hf = 0; hf < 2; ++hf) { float h0[8]; unpack8(__builtin_nontemporal_load((const u32x4*)(hb + row * F2 + c + hf * DFF)), h0);
#pragma unroll
                for (int e = 0; e < 8; ++e) { y[hf][e] = bs[hf][e] + w0[hf][e] * h2[hf][e] + w1[hf][e] * h1[hf][e] + w2[hf][e] * h0[e]; h2[hf][e] = h1[hf][e]; h1[hf][e] = h0[e]; } }
            u32x4 w; float o[8];
#pragma unroll
            for (int e = 0; e < 8; ++e) o[e] = y[0][e] * sigmoidf_(y[0][e]) * y[1][e];
            w.x = cvt_pk_bf16(o[0], o[1]); w.y = cvt_pk_bf16(o[2], o[3]); w.z = cvt_pk_bf16(o[4], o[5]); w.w = cvt_pk_bf16(o[6], o[7]);
            *(u32x4*)(g + row * DFF + c) = w; }
    }
    for (size_t i = gtid; i < (size_t)(MP - MPR) * NCG; i += gsz) { const int row = MPR + (int)(i / NCG), c = (int)(i % NCG) * 8; u32x4 w = {0u, 0u, 0u, 0u};
        if (row < MTOK) { float y[2][8];
#pragma unroll
            for (int hf = 0; hf < 2; ++hf) { const int cc = c + hf * DFF; float h0[8]; unpack8(*(const u32x4*)(hb + (size_t)row * F2 + cc), h0);
                const float* s0 = sc + ((size_t)(row - MPR) * 2) * F2 + cc; const float* s1 = s0 + F2;
#pragma unroll
                for (int e = 0; e < 8; ++e) y[hf][e] = cb[cc + e] + cw[cc + e] * s0[e] + cw[F2 + cc + e] * s1[e] + cw[2 * F2 + cc + e] * h0[e]; }
            float o[8];
#pragma unroll
            for (int e = 0; e < 8; ++e) o[e] = y[0][e] * sigmoidf_(y[0][e]) * y[1][e];
            w.x = cvt_pk_bf16(o[0], o[1]); w.y = cvt_pk_bf16(o[2], o[3]); w.z = cvt_pk_bf16(o[4], o[5]); w.w = cvt_pk_bf16(o[6], o[7]); }
        *(u32x4*)(g + (size_t)row * DFF + c) = w; }
    for (size_t i = gtid; i < (size_t)NS * F2; i += gsz) { const int r = (int)(i / F2), c = (int)(i % F2); P.out[O_CONVS + ((size_t)r * 2) * F2 + c] = sc[((size_t)r * 2 + 1) * F2 + c]; }
}

template <class Epi> __device__ __forceinline__ void run_gemm(unsigned char* smem, const bf16_t* A, const bf16_t* Bt, int M, int N, int K, const Epi& E) {
    pg8::Gemm g{A, Bt, M, N, K, K}; pg8::StaticOrder S; S.init(M, N, (int)gridDim.x, (int)blockIdx.x);
    pg8::gemm_phase<Epi, pg8::StaticOrder, false>((PG8_LAS unsigned char*)smem, g, S, E, nullptr);
}
static __device__ __forceinline__ void run_split(unsigned char* smem, const bf16_t* A, const bf16_t* Bt, int K, int ks, float* accb, int ld = 0, int kbase = 0) {
    if (ld == 0) ld = K;
    pg8::Gemm g{A, Bt, MP, D, ks, ld}; SplitOrder S{8 * (K / ks), (int)gridDim.x, (int)blockIdx.x, ks, kbase}; EpiAtomic E{accb};
    pg8::gemm_phase<EpiAtomic, SplitOrder, false>((PG8_LAS unsigned char*)smem, g, S, E, nullptr);
}

__global__ void __launch_bounds__(512) fwd_kernel(Params P) {
    extern __shared__ __attribute__((aligned(16))) unsigned char smem[];
    cg::grid_group grid = cg::this_grid();
    const int lo = P.ph_lo, hi = P.ph_hi;
    unsigned char* ws = P.ws;
    const int G = (int)gridDim.x, bx = (int)blockIdx.x;
#define PH(k) (lo <= (k) && (k) < hi)
    volatile LAS unsigned* xst = (volatile LAS unsigned*)(smem + 131072 + 512);
    if (threadIdx.x == 0) { xst[0] = 0u; xst[1] = 0u; }
    __syncthreads();
    const XcdBarrier xb = xcd_barrier_post((unsigned*)(ws + WS_BAR) + (size_t)P.li * XCD_BAR_WORDS, xst);
#define SEAM(k) do { if ((k) + 1 < hi) { if (P.pad == 77) grid.sync(); else xcd_barrier(xb); } } while (0)
    if (PH(0)) { { float* az = (float*)(ws + WS_ADA); for (size_t i = (size_t)bx * 512 + threadIdx.x; i < (size_t)132 * NADA; i += (size_t)G * 512) az[i] = 0.f; }
        { float* ab = (float*)(ws + WS_ACC); for (size_t i = (size_t)bx * 512 + threadIdx.x; i < (size_t)4 * NS * D; i += (size_t)G * 512) ab[i] = 0.f; }
        transpose_job(P.in[I_WADA], D, NADA, (bf16_t*)(ws + WS_RA), 1 << 30, 0, bx, G, (float*)smem); phase_misc0(P); SEAM(0); }
    if (PH(1)) {
        {
            pg8::Gemm g{(const bf16_t*)(ws + WS_AADA), (const bf16_t*)(ws + WS_RA), 256, NADA, 1024, D}; AdaOrder S{96, G, bx}; EpiAda E{(float*)(ws + WS_ADA), P.in[I_BADA]};
            pg8::gemm_phase<EpiAda, AdaOrder, false>((PG8_LAS unsigned char*)smem, g, S, E, nullptr); }
        const int first = G > 192 ? 96 : 0;
        if (bx >= first) { const int part = bx - first, np = G - first;
            transpose_job(P.in[I_WIN], D, 11552, (bf16_t*)(ws + WS_WIN), PRW, C_Q - PRW, part, np, (float*)smem);
            phase_misc1(P, (size_t)part * 512 + threadIdx.x, (size_t)np * 512); }
        SEAM(1); }
    if (PH(2)) { phase_modulate(P); SEAM(2); }
    if (PH(3)) { EpiBf16P E{(bf16_t*)(ws + WS_RA), NINP}; run_gemm(smem, (const bf16_t*)(ws + WS_RC), (const bf16_t*)(ws + WS_WIN), MP, NINP, D, E); SEAM(3); }
    if (PH(4)) { phase_lora_in(P); SEAM(4); }
    if (PH(5)) { float* dec = (float*)(ws + WS_RB); EpiLora E{dec, dec + (size_t)MP * RW, (bf16_t*)(dec + (size_t)2 * MP * RW), P.in[I_W0], P.in[I_A0]};
        run_gemm(smem, (const bf16_t*)(ws + WS_ALORA), (const bf16_t*)(ws + WS_WLORA), MP, NL, KL, E); SEAM(5); }
    if (PH(7)) {
        if (G >= 192) {
            const int sel = P.pad;
            if (bx < 128) { if (sel == 0 || sel == 1) rwkv_prompt_item(P, bx, smem); }
            else if (bx < 160) { if (sel == 0 || sel == 2) ret_prompt_item(P, (bx - 128) >> 3, (bx - 128) & 7, smem); }
            else if (sel == 0 || sel == 3) { const int part = bx - 160, np = G - 160;
                for (int pr = part * 8 + (int)(threadIdx.x >> 6); pr < NS * 16; pr += np * 8) rwkv_sample_pair(P, pr);
                __syncthreads();
                for (int pr = part; pr < NS * 8; pr += np) ret_sample_pair(P, pr, smem);
                transpose_job(P.in[I_WBA], RW, D, (bf16_t*)(ws + WS_WBA), 1 << 30, 0, part, np, (float*)smem, D, 0);
                transpose_job(P.in[I_WBB], RW, D, (bf16_t*)(ws + WS_WBA), 1 << 30, 0, part, np, (float*)smem, D, RW);
                transpose_job(P.in[I_WOUT], D, D, (bf16_t*)(ws + WS_WOUT), 1 << 30, 0, part, np, (float*)smem);
                transpose_job(P.in[I_WUP], D, F2, (bf16_t*)(ws + WS_WUP), 1 << 30, 0, part, np, (float*)smem);
                transpose_job(P.in[I_WDOWN], DFF, D, (bf16_t*)(ws + WS_WDOWN), 1 << 30, 0, part, np, (float*)smem); }
        } else {
            for (int it = bx; it < 128; it += G) rwkv_prompt_item(P, it, smem);
            for (int it = bx; it < 32; it += G) ret_prompt_item(P, it >> 3, it & 7, smem);
            for (int pr = bx * 8 + (int)(threadIdx.x >> 6); pr < NS * 16; pr += G * 8) rwkv_sample_pair(P, pr);
            __syncthreads();
            for (int pr = bx; pr < NS * 8; pr += G) ret_sample_pair(P, pr, smem);
            transpose_job(P.in[I_WBA], RW, D, (bf16_t*)(ws + WS_WBA), 1 << 30, 0, bx, G, (float*)smem, D, 0);
            transpose_job(P.in[I_WBB], RW, D, (bf16_t*)(ws + WS_WBA), 1 << 30, 0, bx, G, (float*)smem, D, RW);
            transpose_job(P.in[I_WOUT], D, D, (bf16_t*)(ws + WS_WOUT), 1 << 30, 0, bx, G, (float*)smem);
            transpose_job(P.in[I_WUP], D, F2, (bf16_t*)(ws + WS_WUP), 1 << 30, 0, bx, G, (float*)smem);
            transpose_job(P.in[I_WDOWN], DFF, D, (bf16_t*)(ws + WS_WDOWN), 1 << 30, 0, bx, G, (float*)smem);
        }
        SEAM(7); }
    if (PH(8)) { phase_post(P); SEAM(8); }
    if (PH(9)) { const bf16_t* ya = (const bf16_t*)(ws + WS_RD);
        float* accb = (float*)(ws + WS_ACC);
        const bf16_t* wab = (const bf16_t*)(ws + WS_WBA);
        EpiMerged EM{(const bf16_t*)(ws + WS_RA), (bf16_t*)(ws + WS_RC)}; run_gemm(smem, ya, wab, MPR, D, D, EM);
        run_split(smem, ya, wab, RW, 256, accb, D, 0);
        run_split(smem, ya, wab, RW, 256, accb + (size_t)NS * D, D, RW);
        xcd_barrier(xb);
        {
            const bf16_t* proj = (const bf16_t*)(ws + WS_RA); bf16_t* mg = (bf16_t*)(ws + WS_RC);
            for (size_t i = (size_t)bx * 512 + threadIdx.x; i < (size_t)256 * D; i += (size_t)G * 512) { const int r = (int)(i >> 11), cc = (int)(i & (D - 1)); float v = 0.f;
                if (r < NS) { const size_t row = (size_t)MPR + r; v = sigmoidf_(bf2f(proj[row * NINP + C_GA + cc])) * accb[(size_t)r * D + cc] + sigmoidf_(bf2f(proj[row * NINP + C_GB + cc])) * accb[(size_t)(NS + r) * D + cc]; }
                mg[((size_t)MPR + r) * D + cc] = f2bf(v); } }
        SEAM(9); }
    if (PH(10)) { EpiRes<0> E{P.in[I_XP], (const float*)(ws + WS_ADA), (bf16_t*)(ws + WS_RD), P.out}; run_gemm(smem, (const bf16_t*)(ws + WS_RC), (const bf16_t*)(ws + WS_WOUT), MPR, D, D, E);
        run_split(smem, (const bf16_t*)(ws + WS_RC), (const bf16_t*)(ws + WS_WOUT), D, 256, (float*)(ws + WS_ACC) + (size_t)2 * NS * D); SEAM(10); }
    if (PH(11)) { phase_ln<0>(P); SEAM(11); }
    if (PH(12)) { EpiUp E{(bf16_t*)(ws + WS_RA), P.out}; run_gemm(smem, (const bf16_t*)(ws + WS_RC), (const bf16_t*)(ws + WS_WUP), MP, F2, D, E); SEAM(12); }
    if (PH(13)) { phase_conv(P); SEAM(13); }
    if (PH(14)) { EpiRes<1> E{P.in[I_XP], (const float*)(ws + WS_ADA), (bf16_t*)(ws + WS_RD), P.out}; run_gemm(smem, (const bf16_t*)(ws + WS_RB), (const bf16_t*)(ws + WS_WDOWN), MPR, D, DFF, E);
        run_split(smem, (const bf16_t*)(ws + WS_RB), (const bf16_t*)(ws + WS_WDOWN), DFF, 256, (float*)(ws + WS_ACC) + (size_t)3 * NS * D); SEAM(14); }
    if (PH(15)) { phase_ln<1>(P); }
#undef PH
#undef SEAM
}

extern "C" void kernel_launch(void* const* d_in, const int* in_sizes, int n_in, void* d_out, int out_size, void* d_ws, size_t ws_size, hipStream_t stream) {
    static int grid = 0;
    if (grid == 0) {
        if (n_in != 35 || (size_t)out_size != O_END || ws_size < WS_END) { fprintf(stderr, "kernel_launch: unexpected shapes: n_in %d out %d ws %zu (need %zu)\n", n_in, out_size, ws_size, (size_t)WS_END); grid = -1; return; }
        int dev = 0, cus = 0, per_cu = 0;
        hipGetDevice(&dev); hipDeviceGetAttribute(&cus, hipDeviceAttributeMultiprocessorCount, dev);
        if (hipFuncSetAttribute((const void*)fwd_kernel, hipFuncAttributeMaxDynamicSharedMemorySize, LDS_BYTES) != hipSuccess) { fprintf(stderr, "kernel_launch: hipFuncSetAttribute failed\n"); grid = -1; return; }
        if (hipOccupancyMaxActiveBlocksPerMultiprocessor(&per_cu, (const void*)fwd_kernel, 512, LDS_BYTES) != hipSuccess || per_cu < 1) { fprintf(stderr, "kernel_launch: occupancy query failed (%d)\n", per_cu); (void)hipGetLastError(); per_cu = 1; }
        grid = cus * 1;
        if (grid <= 0) { grid = -1; return; }
    }
    if (grid < 0) return;
    if (hipMemsetAsync((unsigned char*)d_ws + WS_BAR, 0, (size_t)4 * XCD_BAR_WORDS * 4, stream) != hipSuccess) { fprintf(stderr, "kernel_launch: memset of the barrier words failed\n"); return; }
    Params p{};
    for (int i = 0; i < 35; ++i) p.in[i] = (const float*)d_in[i];
    p.out = (float*)d_out; p.ws = (unsigned char*)d_ws;
#if MULTI
    for (int ph = 0; ph <= NPHASE; ++ph) { p.ph_lo = ph; p.ph_hi = ph + 1; hipLaunchKernelGGL(fwd_kernel, dim3(grid), dim3(512), LDS_BYTES, stream, p); }
#else
    void* args[] = {&p};
#if DUPK >= 0
    p.ph_lo = 0; p.ph_hi = DUPK + 1;
    (void)hipLaunchCooperativeKernel((const void*)fwd_kernel, dim3(grid), dim3(512), args, LDS_BYTES, stream);
    p.ph_lo = DUPK; p.ph_hi = NPHASE + 1; p.li = 1;
#ifdef DUPSEL
    p.ph_lo = 7; p.ph_hi = 8; p.pad = DUPSEL;
    (void)hipLaunchCooperativeKernel((const void*)fwd_kernel, dim3(grid), dim3(512), args, LDS_BYTES, stream);
    p.ph_lo = 8; p.ph_hi = NPHASE + 1; p.pad = 0; p.li = 2;
#endif
    (void)hipLaunchCooperativeKernel((const void*)fwd_kernel, dim3(grid), dim3(512), args, LDS_BYTES, stream);
#else
    p.ph_lo = 0; p.ph_hi = NPHASE + 1;
    hipError_t e = hipLaunchCooperativeKernel((const void*)fwd_kernel, dim3(grid), dim3(512), args, LDS_BYTES, stream);
    if (e != hipSuccess) fprintf(stderr, "cooperative launch failed: %s (grid %d)\n", hipGetErrorString(e), grid);
#endif
#endif
}
```

```cpp
#include <hip/hip_runtime.h>
#include <hip/hip_cooperative_groups.h>
#include <cstdio>
namespace cg = cooperative_groups;
#define MULTI 0
#define DUPK -1
#define DUPS 1
namespace pg8 {
#define PG8_LAS __attribute__((address_space(3)))
typedef unsigned short bf16_t;
typedef short bf16x8 __attribute__((ext_vector_type(8)));
typedef float f32x4 __attribute__((ext_vector_type(4)));
typedef unsigned u32x4 __attribute__((ext_vector_type(4)));
constexpr int BM = 256, BK = 64, HALF = 128, HTB = HALF * BK * 2  , STAGE_BYTES = 8 * HTB, NXCD = 8, WGM = 8;

__host__ __device__ __forceinline__ int lds_byte(int r, int c) { const int st = (r >> 4) * 2 + (c >> 5), rr = r & 15, cc = c & 31, ob = rr * 64 + cc * 2; return st * 1024 + (ob ^ (((ob >> 9) & 1) << 5)); }
__host__ __device__ __forceinline__ void stage_rc(int b, int& R, int& C) { const int st = b / 1024, sb = b % 1024, swz = sb ^ (((sb >> 9) & 1) << 5); R = (st >> 1) * 16 + swz / 64; C = (st & 1) * 32 + (swz % 64) / 2; }
__host__ __device__ __forceinline__ int perm32(int rho) { const int n = rho >> 4, i = rho & 15; return 8 * (i >> 2) + 4 * n + (i & 3); }

struct Unit { int pm, pn, k0; };
struct Gemm { const bf16_t* A; const bf16_t* Bt; int M, N, K, ld; };

struct StaticOrder {
    int nM, nN, nwg, G, c;
    __host__ __device__ void init(int M, int N, int G_, int c_) { nM = M / BM; nN = N / BM; nwg = nM * nN; G = G_; c = c_; }
    __host__ __device__ bool next(int i, Unit& u) const {
        const long L = (long)i * G + c; if (L >= nwg) return false;
        int wgid = (int)L; { const int q = nwg / NXCD, r = nwg % NXCD, xcd = wgid % NXCD, off = wgid / NXCD; wgid = (xcd < r ? xcd * (q + 1) : r * (q + 1) + (xcd - r) * q) + off; }
        const int nig = WGM * nN, gid = wgid / nig, fm = gid * WGM, gsz = (nM - fm) < WGM ? (nM - fm) : WGM;
        u.pm = fm + ((wgid % nig) % gsz); u.pn = (wgid % nig) / gsz; u.k0 = 0; return true;
    }
    __device__ __forceinline__ void a_ready(const Unit&) const {}
    __device__ __forceinline__ void done(const Unit&) const {}
};
__device__ __forceinline__ unsigned cvt_pk_bf16(float lo, float hi) { unsigned r; asm volatile("v_cvt_pk_bf16_f32 %0, %1, %2" : "=v"(r) : "v"(lo), "v"(hi)); return r; }
typedef float f32x2 __attribute__((ext_vector_type(2)));
template <class Epi, class Sched, bool STAMP = false>
__device__ __forceinline__ void gemm_phase(PG8_LAS unsigned char* lds, const Gemm g, const Sched& S, const Epi& E, unsigned long long* stamps) {
    const int tid = threadIdx.x, wid = __builtin_amdgcn_readfirstlane(tid >> 6), lane = tid & 63, wr = wid >> 2, wc = wid & 3, fr = lane & 15, fq = lane >> 4;
    const int K = g.K, nt = K / BK, LD = g.ld;
    int ts_lo = 0, ts_hi = 0, nts = 0; const unsigned long long rt_entry = STAMP ? (unsigned long long)wall_clock64() : 0ull;
#define PG8_STAMP() do { if (STAMP && wid == 0 && nts < 64) { const unsigned long long _c = (unsigned long long)clock64(); \
        ts_lo = (lane == nts) ? (int)(unsigned)_c : ts_lo; ts_hi = (lane == nts) ? (int)(unsigned)(_c >> 32) : ts_hi; ++nts; } } while (0)
    PG8_STAMP();
    unsigned voffA[2], voffB[2];
#pragma unroll
    for (int i = 0; i < 2; ++i) { int R, C; stage_rc(tid * 16 + i * 8192, R, C); const int Rb = Epi::PERM ? ((R & ~31) + perm32(R & 31)) : R;
        voffA[i] = (unsigned)(R * LD + C) * 2u; voffB[i] = (unsigned)(Rb * LD + C) * 2u; }
    const size_t kstep = (size_t)(BK * 2);
    const size_t hstep = (size_t)HALF * LD * 2;
    const size_t tstep = 2 * hstep;
    const unsigned ldsw = (unsigned)wid * 1024u;
    const int aoff = lds_byte(wr * 64 + fr, fq * 8), boff = lds_byte(wc * 32 + fr, fq * 8);
#define PG8_SA(b, h) (((b) * 2 + (h)) * HTB)
#define PG8_SB(b, h) ((4 + (b) * 2 + (h)) * HTB)
#define PG8_STAGE(bufoff, gbase, voff) do { _Pragma("unroll") for (int _i = 0; _i < 2; ++_i) \
        __builtin_amdgcn_global_load_lds((const unsigned*)((const char*)(gbase) + (voff)[_i]), (PG8_LAS unsigned*)(lds + (bufoff) + ldsw + _i * 8192), 16, 0, 0); } while (0)
#define PG8_LDA(dst, b, h) do { _Pragma("unroll") for (int m = 0; m < 4; ++m) _Pragma("unroll") for (int k = 0; k < 2; ++k) dst[m][k] = *(const PG8_LAS bf16x8*)(lds + PG8_SA(b, h) + aoff + m * 2048 + k * 1024); } while (0)
#define PG8_LDB(dst, b, h) do { _Pragma("unroll") for (int n = 0; n < 2; ++n) _Pragma("unroll") for (int k = 0; k < 2; ++k) dst[n][k] = *(const PG8_LAS bf16x8*)(lds + PG8_SB(b, h) + boff + n * 2048 + k * 1024); } while (0)
#define PG8_MMA(ai, bj, At, Bt) do { __builtin_amdgcn_s_setprio(1); _Pragma("unroll") for (int m = 0; m < 4; ++m) _Pragma("unroll") for (int n = 0; n < 2; ++n) _Pragma("unroll") for (int k = 0; k < 2; ++k) \
        acc[ai][bj][m][n] = __builtin_amdgcn_mfma_f32_16x16x32_bf16(Bt[n][k], At[m][k], acc[ai][bj][m][n], 0, 0, 0); __builtin_amdgcn_s_setprio(0); } while (0)
#define PG8_WAIT_V(n) asm volatile("s_waitcnt vmcnt(" #n ")" ::: "memory")
#define PG8_WAIT_L(n) asm volatile("s_waitcnt lgkmcnt(" #n ")" ::: "memory")
#define PG8_BAR __builtin_amdgcn_s_barrier()
#define PG8_SCHED __builtin_amdgcn_sched_barrier(0)
    Unit cur, nxt; int ui = 0;
    if (!S.next(0, cur)) return;
    f32x4 acc[2][2][4][2];
#pragma unroll
    for (int a = 0; a < 2; ++a)
#pragma unroll
        for (int b = 0; b < 2; ++b)
#pragma unroll
            for (int m = 0; m < 4; ++m)
#pragma unroll
                for (int n = 0; n < 2; ++n) acc[a][b][m][n] = (f32x4){0.f, 0.f, 0.f, 0.f};
    bf16x8 At[4][2], B0[2][2], B1[2][2];
    const char* cA = (const char*)g.A + (size_t)cur.pm * tstep + (size_t)cur.k0 * 2; const char* cB = (const char*)g.Bt + (size_t)cur.pn * tstep + (size_t)cur.k0 * 2;
    S.a_ready(cur);
    PG8_STAGE(PG8_SB(0, 0), cB, voffB); PG8_STAGE(PG8_SA(0, 0), cA, voffA); PG8_STAGE(PG8_SB(0, 1), cB + hstep, voffB); PG8_STAGE(PG8_SA(0, 1), cA + hstep, voffA);
    if (wr == 1) PG8_BAR;
    PG8_WAIT_V(4); PG8_BAR;
    PG8_STAGE(PG8_SB(1, 0), cB + kstep, voffB); PG8_STAGE(PG8_SA(1, 0), cA + kstep, voffA); PG8_STAGE(PG8_SB(1, 1), cB + hstep + kstep, voffB);
    PG8_WAIT_V(6); PG8_BAR;
    PG8_STAMP();
    for (;;) {
        const bool has_next = S.next(ui + 1, nxt);
        const char* nA = has_next ? (const char*)g.A + (size_t)nxt.pm * tstep + (size_t)nxt.k0 * 2 : cA; const char* nB = has_next ? (const char*)g.Bt + (size_t)nxt.pn * tstep + (size_t)nxt.k0 * 2 : cB;
        for (int hk = 0; hk < (Epi::HAS_MID ? 2 : 1); ++hk) {
        const int tb = Epi::HAS_MID ? hk * (nt / 2) : 0, te = Epi::HAS_MID ? tb + nt / 2 : nt;
        for (int t = tb; t < te; t += 2) {
            const bool last = (t == nt - 2);
            const char* a1 = cA + (size_t)(t + 1) * kstep;
            const char* a2 = last ? nA : cA + (size_t)(t + 2) * kstep; const char* b2 = last ? nB : cB + (size_t)(t + 2) * kstep;
            const char* a3 = a2 + kstep; const char* b3 = b2 + kstep;
            if (last && has_next) S.a_ready(nxt);
            PG8_LDB(B0, 0, 0); PG8_SCHED; PG8_LDA(At, 0, 0); PG8_STAGE(PG8_SA(1, 1), a1 + hstep, voffA);
            PG8_WAIT_L(8); PG8_BAR; PG8_WAIT_L(0); PG8_MMA(0, 0, At, B0); PG8_BAR; PG8_SCHED;
            PG8_LDB(B1, 0, 1); PG8_STAGE(PG8_SB(0, 0), b2, voffB);
            PG8_BAR; PG8_WAIT_L(0); PG8_MMA(0, 1, At, B1); PG8_BAR;
            PG8_LDA(At, 0, 1); PG8_STAGE(PG8_SA(0, 0), a2, voffA);
            PG8_BAR; PG8_WAIT_L(0); PG8_MMA(1, 0, At, B0); PG8_BAR; PG8_SCHED;
            PG8_STAGE(PG8_SB(0, 1), b2 + hstep, voffB);
            PG8_WAIT_V(6); PG8_BAR; PG8_MMA(1, 1, At, B1); PG8_BAR;
            PG8_LDB(B0, 1, 0); PG8_SCHED; PG8_LDA(At, 1, 0); PG8_STAGE(PG8_SA(0, 1), a2 + hstep, voffA);
            PG8_WAIT_L(8); PG8_BAR; PG8_WAIT_L(0); PG8_MMA(0, 0, At, B0); PG8_BAR; PG8_SCHED;
            PG8_LDB(B1, 1, 1); PG8_STAGE(PG8_SB(1, 0), b3, voffB);
            PG8_BAR; PG8_WAIT_L(0); PG8_MMA(0, 1, At, B1); PG8_BAR;
            PG8_LDA(At, 1, 1); PG8_STAGE(PG8_SA(1, 0), a3, voffA);
            PG8_BAR; PG8_WAIT_L(0); PG8_MMA(1, 0, At, B0); PG8_BAR; PG8_SCHED;
            PG8_STAGE(PG8_SB(1, 1), b3 + hstep, voffB);
            PG8_WAIT_V(6); PG8_BAR; PG8_MMA(1, 1, At, B1); PG8_BAR;
        }
        if constexpr (Epi::HAS_MID) { if (hk == 0) E.mid(acc, cur, wr, wc, fr, fq); }
        }
        PG8_STAMP();
        if constexpr (!Epi::AFTER_DRAIN) { E(acc, cur, wr, wc, fr, fq); S.done(cur); }
        PG8_STAMP();
        if (!has_next) break;
#pragma unroll
        for (int a = 0; a < 2; ++a)
#pragma unroll
            for (int b = 0; b < 2; ++b)
#pragma unroll
                for (int m = 0; m < 4; ++m)
#pragma unroll
                    for (int n = 0; n < 2; ++n) acc[a][b][m][n] = (f32x4){0.f, 0.f, 0.f, 0.f};
        cur = nxt; cA = nA; cB = nB; ++ui;
    }
    PG8_WAIT_V(0);
    if (wr == 0) PG8_BAR;
    PG8_BAR;
    if constexpr (Epi::AFTER_DRAIN) { E.fused(acc, cur, wr, wc, fr, fq, lds, wid, lane); S.done(cur); }
    PG8_STAMP();
    if (STAMP && wid == 0) { stamps[lane] = lane < nts ? (((unsigned long long)(unsigned)ts_hi << 32) | (unsigned)ts_lo) : 0ull;
        if (lane == 62) stamps[62] = rt_entry; if (lane == 63) stamps[63] = (unsigned long long)wall_clock64(); }
#undef PG8_STAMP
#undef PG8_SA
#undef PG8_SB
#undef PG8_STAGE
#undef PG8_LDA
#undef PG8_LDB
#undef PG8_MMA
#undef PG8_WAIT_V
#undef PG8_WAIT_L
#undef PG8_BAR
#undef PG8_SCHED
}
}

using pg8::bf16_t; using pg8::f32x4; using pg8::u32x4; using pg8::Unit; using pg8::BM; using pg8::HALF; using pg8::cvt_pk_bf16; using pg8::bf16x8;
typedef unsigned u32x2 __attribute__((ext_vector_type(2)));

#ifndef MULTI
#define MULTI 0
#endif

constexpr int D = 2048, SEQ = 2048, NB = 4, NS = 128;
constexpr int MPR = NB * SEQ;
constexpr int MTOK = MPR + NS;
constexpr int MP = 8448;
constexpr int RW = 1024, PRW = 3360;
constexpr int NINP = 11776;
constexpr int C_Q = 3584, C_K = 4608, C_V = 5632, C_RG = 6656, C_GA = 7680, C_GB = 9728;
constexpr int F2 = 11264, DFF = 5632;
constexpr int KL = 384, NL = 3072;
constexpr int NADA = 12288;
constexpr float ALPHA = 1.189207115002721f;
constexpr int NPHASE = 15;
constexpr int LDS_BYTES = 131072 + 1024;

constexpr size_t O_YP = 0;
constexpr size_t O_YS = O_YP + (size_t)MPR * D;
constexpr size_t O_WKVP = O_YS + (size_t)NS * D;
constexpr size_t O_SHIFTP = O_WKVP + (size_t)NB * 16 * 64 * 64;
constexpr size_t O_RETP = O_SHIFTP + (size_t)NB * PRW;
constexpr size_t O_CONVP = O_RETP + (size_t)NB * 8 * 128 * 128;
constexpr size_t O_WKVS = O_CONVP + (size_t)NB * 2 * F2;
constexpr size_t O_SHIFTS = O_WKVS + (size_t)NS * 16 * 64 * 64;
constexpr size_t O_RETS = O_SHIFTS + (size_t)NS * PRW;
constexpr size_t O_CONVS = O_RETS + (size_t)NS * 8 * 128 * 128;
constexpr size_t O_END = O_CONVS + (size_t)NS * 2 * F2;

constexpr size_t al256(size_t x) { return (x + 255) & ~(size_t)255; }
constexpr size_t WS_WIN = 0;
constexpr size_t WS_WUP = al256(WS_WIN + (size_t)NINP * D * 2);
constexpr size_t WS_WDOWN = al256(WS_WUP + (size_t)F2 * D * 2);
constexpr size_t WS_WOUT = al256(WS_WDOWN + (size_t)D * DFF * 2);
constexpr size_t WS_WBA = al256(WS_WOUT + (size_t)D * D * 2);
constexpr size_t WS_WBB = al256(WS_WBA + (size_t)D * RW * 2);
constexpr size_t WS_WLORA = al256(WS_WBB + (size_t)D * RW * 2);
constexpr size_t WS_ADA = al256(WS_WLORA + (size_t)NL * KL * 2);
constexpr size_t WS_AADA = al256(WS_ADA + (size_t)132 * NADA * 4);
constexpr size_t WS_ROPE = al256(WS_AADA + (size_t)256 * D * 2);
constexpr size_t WS_BONUS = al256(WS_ROPE + (size_t)2049 * 64 * 4 * 2);
constexpr size_t WS_ALORA = al256(WS_BONUS + (size_t)MTOK * 16 * 4);
constexpr size_t WS_RC = al256(WS_ALORA + (size_t)MP * KL * 2);
constexpr size_t WS_RD = al256(WS_RC + (size_t)MP * D * 2);
constexpr size_t WS_RA = al256(WS_RD + (size_t)MP * D * 2);
constexpr size_t WS_RB = al256(WS_RA + (size_t)MP * NINP * 2);
constexpr size_t WS_ACC = al256(WS_RB + (size_t)MP * DFF * 2);
constexpr size_t WS_BAR = al256(WS_ACC + (size_t)4 * NS * D * 4);
constexpr size_t WS_END = al256(WS_BAR + (size_t)4 * 3456 * 4);

#ifndef DUPK
#define DUPK -1
#endif
struct Params { const float* in[35]; float* out; unsigned char* ws; int ph_lo, ph_hi, li, pad; };

enum { I_XP = 0, I_XS, I_CP, I_CS, I_SWKV, I_SSHIFT, I_SRET, I_SCONV, I_WADA, I_BADA, I_WIN, I_MU, I_W0, I_WDEC, I_A0, I_WAAA, I_WGATE, I_KK, I_KA, I_RK,
       I_LNXW, I_LNXB, I_RGNW, I_RGNB, I_WBA, I_WBB, I_WOUT, I_LN1W, I_LN1B, I_WUP, I_CONVW, I_CONVB, I_WDOWN, I_LN2W, I_LN2B };

__device__ __forceinline__ float bf2f(bf16_t v) { return __uint_as_float(((unsigned)v) << 16); }
__device__ __forceinline__ bf16_t f2bf(float f) { unsigned u = __float_as_uint(f); u += 0x7FFFu + ((u >> 16) & 1u); return (bf16_t)(u >> 16); }
__device__ __forceinline__ float lo_bf(unsigned w) { return __uint_as_float(w << 16); }
__device__ __forceinline__ float hi_bf(unsigned w) { return __uint_as_float(w & 0xffff0000u); }
template <int CTRL> __device__ __forceinline__ float dpp_f(float x) { return __int_as_float(__builtin_amdgcn_update_dpp(0, __float_as_int(x), CTRL, 0xF, 0xF, true)); }
__device__ __forceinline__ float row16_sum(float x) { x += dpp_f<0xB1>(x); x += dpp_f<0x4E>(x); x += dpp_f<0x141>(x); x += dpp_f<0x140>(x); return x; }
__device__ __forceinline__ float wave_sum(float x) {
    x = row16_sum(x); const int xi = __float_as_int(x);
    const float a = __int_as_float(__builtin_amdgcn_readlane(xi, 0)), b = __int_as_float(__builtin_amdgcn_readlane(xi, 16)), c = __int_as_float(__builtin_amdgcn_readlane(xi, 32)), d = __int_as_float(__builtin_amdgcn_readlane(xi, 48));
    return (a + b) + (c + d);
}
__device__ __forceinline__ float sigmoidf_(float x) { return __builtin_amdgcn_rcpf(1.0f + __expf(-x)); }
__device__ __forceinline__ int ada_row(int row) { return row < MPR ? (row >> 11) : 4 + (row - MPR); }


#define XB_TMO      128
#define XB_XCNT(j)  (256  + 64 * (j))
#define XB_XSUB(j)  (1280 + 64 * (j))
#define XB_XGEN(j)  (2304 + 64 * (j))
#define XB_TOP      3328
#define XB_TOPGEN   3392
#define XCD_BAR_WORDS 3456
#define XB_SPIN_CAP (1u << 18)
#define LAS __attribute__((address_space(3)))
__device__ __forceinline__ unsigned xb_ld(unsigned* p)              { return __hip_atomic_load(p, __ATOMIC_RELAXED, __HIP_MEMORY_SCOPE_AGENT); }
__device__ __forceinline__ unsigned xb_add(unsigned* p, unsigned v) { return __hip_atomic_fetch_add(p, v, __ATOMIC_RELAXED, __HIP_MEMORY_SCOPE_AGENT); }
__device__ __forceinline__ unsigned xb_xcc_id() { return (unsigned)__builtin_amdgcn_s_getreg((3 << 11) | 20) & 0xFu; }
#define XB_SPIN(cond, bar) do { unsigned _sp = 0; while (cond) { __builtin_amdgcn_s_sleep(1); \
    if ((++_sp & 255u) == 0u) { if (xb_ld(&(bar)[XB_TMO])) break; if (_sp > XB_SPIN_CAP) { atomicAdd(&(bar)[XB_TMO], 1u); break; } } } } while (0)
struct XcdBarrier { unsigned* bar; unsigned x; volatile LAS unsigned* st; };
__device__ __forceinline__ XcdBarrier xcd_barrier_post(unsigned* bar, volatile LAS unsigned* st) {
    XcdBarrier b; b.bar = bar; b.x = xb_xcc_id(); b.st = st;
    if (threadIdx.x == 0) (void)xb_add(&bar[XB_XCNT(b.x)], 1u);
    return b;
}
__device__ __forceinline__ void xcd_barrier_complete(unsigned* bar, unsigned x, unsigned& nloc, unsigned& nx) {
    const unsigned G = gridDim.x * gridDim.y * gridDim.z;
    unsigned sum, cnt, mine, sp = 0u;
    for (;;) {
        sum = 0u; cnt = 0u; mine = 0u;
#pragma unroll
        for (unsigned j = 0; j < 16; ++j) { const unsigned c = xb_ld(&bar[XB_XCNT(j)]); sum += c; cnt += (c > 0u) ? 1u : 0u; mine = (j == x) ? c : mine; }
        if (sum == G) break;
        __builtin_amdgcn_s_sleep(1);
        if ((++sp & 255u) == 0u) { if (xb_ld(&bar[XB_TMO])) break; if (sp > XB_SPIN_CAP) { atomicAdd(&bar[XB_TMO], 1u); break; } }
    }
    nloc = mine > 0u ? mine : 1u; nx = cnt > 0u ? cnt : 1u;
}
__device__ __forceinline__ void xcd_barrier(const XcdBarrier& b) {
    asm volatile("s_waitcnt vmcnt(0)" ::: "memory");
    __syncthreads();
    if (threadIdx.x == 0) {
        unsigned* bar = b.bar;
        __builtin_amdgcn_s_waitcnt(0);
        unsigned nloc = b.st[0], nx = b.st[1];
        if (nloc == 0u) { xcd_barrier_complete(bar, b.x, nloc, nx); b.st[0] = nloc; b.st[1] = nx; }
        const unsigned old = xb_add(&bar[XB_XSUB(b.x)], 1u);
        const unsigned gen = old / nloc;
        if (old + 1u == (gen + 1u) * nloc) {
            __builtin_amdgcn_fence(__ATOMIC_RELEASE, "agent");
            asm volatile("s_waitcnt vmcnt(0)" ::: "memory");
            const unsigned og = xb_add(&bar[XB_TOP], 1u);
            const unsigned tg = og / nx;
            if (og + 1u == (tg + 1u) * nx) xb_add(&bar[XB_TOPGEN], 1u);
            else XB_SPIN(xb_ld(&bar[XB_TOPGEN]) == tg, bar);
            __builtin_amdgcn_fence(__ATOMIC_ACQUIRE, "agent");
            xb_add(&bar[XB_XGEN(b.x)], 1u);
            asm volatile("s_waitcnt vmcnt(0)" ::: "memory");
        } else {
            XB_SPIN(xb_ld(&bar[XB_XGEN(b.x)]) == gen, bar);
            __builtin_amdgcn_fence(__ATOMIC_ACQUIRE, "agent");
            asm volatile("s_waitcnt vmcnt(0)" ::: "memory");
        }
    }
    __syncthreads();
}

#define RW_BAR() do { asm volatile("s_waitcnt lgkmcnt(0)" ::: "memory"); __builtin_amdgcn_s_barrier(); asm volatile("" ::: "memory"); } while (0)
static __device__ __forceinline__ void transpose_job(const float* __restrict__ W, int K, int N, bf16_t* __restrict__ Wt, int shift_from, int shift, int part, int nparts, float* tl, int ldk = 0, int koff = 0) {
    if (ldk == 0) ldk = K;
    const int tid = threadIdx.x;
    const int nKt = K / 64, nNt = (N + 63) / 64, ntile = nKt * nNt;
    f32x4 v[4][2];
    const int li = tid >> 4, lj = (tid & 15) * 4;
#define TR_LOAD(t, q) do { if ((t) < ntile) { const int nt_ = (t) / nKt, kt_ = (t) - nt_ * nKt; const int n = nt_ * 64 + lj; \
        _Pragma("unroll") for (int e = 0; e < 2; ++e) v[q][e] = (n < N) ? __builtin_nontemporal_load((const f32x4*)(W + (size_t)(kt_ * 64 + li + e * 32) * N + n)) : (f32x4){0.f, 0.f, 0.f, 0.f}; } } while (0)
    int t = part;
#pragma unroll
    for (int q = 0; q < 4; ++q) TR_LOAD(t + q * nparts, q);
    for (; t < ntile; t += 4 * nparts) {
#pragma unroll
        for (int q = 0; q < 4; ++q) if (t + q * nparts < ntile) {
#pragma unroll
            for (int e = 0; e < 2; ++e) { float* d = tl + q * 4160 + (li + e * 32) * 65 + lj; d[0] = v[q][e][0]; d[1] = v[q][e][1]; d[2] = v[q][e][2]; d[3] = v[q][e][3]; } }
        RW_BAR();
#pragma unroll
        for (int q = 0; q < 4; ++q) TR_LOAD(t + (4 + q) * nparts, q);
#pragma unroll
        for (int q = 0; q < 4; ++q) { const int tq = t + q * nparts;
            if (tq < ntile) { const int nt = tq / nKt, kt = tq - nt * nKt, k0 = kt * 64, n0 = nt * 64; const float* s = tl + q * 4160;
#pragma unroll
                for (int e = 0; e < 4; ++e) { const int p = tid + e * 512, j = p >> 5, i = (p & 31) * 2, n = n0 + j;
                    if (n < N) { const int dr = (n >= shift_from) ? n + shift : n;
                        *(unsigned*)(Wt + (size_t)dr * ldk + koff + k0 + i) = cvt_pk_bf16(s[i * 65 + j], s[(i + 1) * 65 + j]); } } } }
        RW_BAR();
    }
#undef TR_LOAD
    __syncthreads();
}

struct SplitOrder { int nunits, G, c, ks, kbase;
    __device__ bool next(int i, Unit& u) const { const int L = i * G + c; if (L >= nunits) return false; u.pm = MPR / 256; u.pn = L & 7; u.k0 = kbase + (L >> 3) * ks; return true; }
    __device__ __forceinline__ void a_ready(const Unit&) const {}
    __device__ __forceinline__ void done(const Unit&) const {}
};
struct AdaOrder { int nunits, G, c;
    __device__ bool next(int i, Unit& u) const { const int L = i * G + c; if (L >= nunits) return false; u.pm = 0; u.pn = L % 48; u.k0 = (L / 48) * 1024; return true; }
    __device__ __forceinline__ void a_ready(const Unit&) const {}
    __device__ __forceinline__ void done(const Unit&) const {}
};
struct EpiAda { static constexpr bool HAS_MID = false, PERM = false, AFTER_DRAIN = false; float* ada; const float* b_ada;
    __device__ __forceinline__ void operator()(const f32x4 (&acc)[2][2][4][2], const Unit& u, int wr, int wc, int fr, int fq) const {
        const int row0 = u.pm * BM + wr * 64 + fr, col0 = u.pn * BM + wc * 32 + 4 * fq;
#pragma unroll
        for (int ai = 0; ai < 2; ++ai)
#pragma unroll
            for (int m = 0; m < 4; ++m) { const int row = row0 + ai * HALF + m * 16;
                if (row < 132) {
#pragma unroll
                    for (int bj = 0; bj < 2; ++bj)
#pragma unroll
                        for (int n = 0; n < 2; ++n) { const int col = col0 + bj * HALF + n * 16; f32x4 v = acc[ai][bj][m][n];
                            if (u.k0 == 0) v += *(const f32x4*)(b_ada + col);
                            float* p = ada + (size_t)row * NADA + col;
#pragma unroll
                            for (int j = 0; j < 4; ++j) unsafeAtomicAdd(p + j, v[j]); } } }
    }
};
struct EpiBf16P { static constexpr bool HAS_MID = false, PERM = true, AFTER_DRAIN = false; bf16_t* O; int ldc;
    __device__ __forceinline__ void operator()(const f32x4 (&acc)[2][2][4][2], const Unit& u, int wr, int wc, int fr, int fq) const {
        const int row0 = u.pm * BM + wr * 64 + fr, col0 = u.pn * BM + wc * 32 + 8 * fq;
#pragma unroll
        for (int ai = 0; ai < 2; ++ai)
#pragma unroll
            for (int m = 0; m < 4; ++m) { bf16_t* rowp = O + (size_t)(row0 + ai * HALF + m * 16) * ldc + col0;
#pragma unroll
                for (int bj = 0; bj < 2; ++bj) { const f32x4 v0 = acc[ai][bj][m][0], v1 = acc[ai][bj][m][1];
                    u32x4 w; w.x = cvt_pk_bf16(v0[0], v0[1]); w.y = cvt_pk_bf16(v0[2], v0[3]); w.z = cvt_pk_bf16(v1[0], v1[1]); w.w = cvt_pk_bf16(v1[2], v1[3]);
                    *(u32x4*)(rowp + bj * HALF) = w; } }
    }
};
struct EpiUp { static constexpr bool HAS_MID = false, PERM = true, AFTER_DRAIN = false; bf16_t* O; float* out;
    __device__ __forceinline__ void operator()(const f32x4 (&acc)[2][2][4][2], const Unit& u, int wr, int wc, int fr, int fq) const {
        const int row0 = u.pm * BM + wr * 64 + fr, col0 = u.pn * BM + wc * 32 + 8 * fq;
#pragma unroll
        for (int ai = 0; ai < 2; ++ai)
#pragma unroll
            for (int m = 0; m < 4; ++m) { const int row = row0 + ai * HALF + m * 16; bf16_t* rowp = O + (size_t)row * F2 + col0;
                float* cdst = nullptr;
                if (row < MPR) { const int t = row & (SEQ - 1); if (t >= SEQ - 2) cdst = out + O_CONVP + ((size_t)(row >> 11) * 2 + (t - (SEQ - 2))) * F2; }
                else if (row < MTOK) cdst = out + O_CONVS + ((size_t)(row - MPR) * 2 + 1) * F2;
#pragma unroll
                for (int bj = 0; bj < 2; ++bj) { const f32x4 v0 = acc[ai][bj][m][0], v1 = acc[ai][bj][m][1];
                    u32x4 w; w.x = cvt_pk_bf16(v0[0], v0[1]); w.y = cvt_pk_bf16(v0[2], v0[3]); w.z = cvt_pk_bf16(v1[0], v1[1]); w.w = cvt_pk_bf16(v1[2], v1[3]);
                    *(u32x4*)(rowp + bj * HALF) = w;
                    if (cdst) { *(f32x4*)(cdst + col0 + bj * HALF) = v0; *(f32x4*)(cdst + col0 + bj * HALF + 4) = v1; } } }
    }
};
struct EpiLora { static constexpr bool HAS_MID = false, PERM = false, AFTER_DRAIN = false; float* dec; float* aa; bf16_t* gg; const float* w0; const float* a0;
    __device__ __forceinline__ void operator()(const f32x4 (&acc)[2][2][4][2], const Unit& u, int wr, int wc, int fr, int fq) const {
        const int kind = u.pn >> 2;
        const int row0 = u.pm * BM + wr * 64 + fr, col0 = (u.pn & 3) * BM + wc * 32 + 4 * fq;
        if (kind == 0) {
#pragma unroll
            for (int ai = 0; ai < 2; ++ai)
#pragma unroll
                for (int m = 0; m < 4; ++m) { float* rp = dec + (size_t)(row0 + ai * HALF + m * 16) * RW + col0;
#pragma unroll
                    for (int bj = 0; bj < 2; ++bj)
#pragma unroll
                        for (int n = 0; n < 2; ++n) { const f32x4 v = acc[ai][bj][m][n]; f32x4 o; const f32x4 bb = *(const f32x4*)(w0 + col0 + bj * HALF + n * 16);
#pragma unroll
                            for (int j = 0; j < 4; ++j) { const float y = -(bb[j] + v[j]); const float sp = fmaxf(y, 0.f) + __logf(1.0f + __expf(-fabsf(y))); o[j] = __expf(-__expf(-sp - 0.5f)); }
                            *(f32x4*)(rp + bj * HALF + n * 16) = o; } }
        } else if (kind == 1) {
#pragma unroll
            for (int ai = 0; ai < 2; ++ai)
#pragma unroll
                for (int m = 0; m < 4; ++m) { float* rp = aa + (size_t)(row0 + ai * HALF + m * 16) * RW + col0;
#pragma unroll
                    for (int bj = 0; bj < 2; ++bj)
#pragma unroll
                        for (int n = 0; n < 2; ++n) { const f32x4 v = acc[ai][bj][m][n]; f32x4 o; const f32x4 bb = *(const f32x4*)(a0 + col0 + bj * HALF + n * 16);
#pragma unroll
                            for (int j = 0; j < 4; ++j) o[j] = sigmoidf_(bb[j] + v[j]);
                            *(f32x4*)(rp + bj * HALF + n * 16) = o; } }
        } else {
#pragma unroll
            for (int ai = 0; ai < 2; ++ai)
#pragma unroll
                for (int m = 0; m < 4; ++m) { bf16_t* rp = gg + (size_t)(row0 + ai * HALF + m * 16) * RW + col0;
#pragma unroll
                    for (int bj = 0; bj < 2; ++bj)
#pragma unroll
                        for (int n = 0; n < 2; ++n) { const f32x4 v = acc[ai][bj][m][n]; u32x2 w; w.x = cvt_pk_bf16(v[0], v[1]); w.y = cvt_pk_bf16(v[2], v[3]); *(u32x2*)(rp + bj * HALF + n * 16) = w; } }
        }
    }
};
struct EpiAtomic { static constexpr bool HAS_MID = false, PERM = false, AFTER_DRAIN = false; float* accb;
    __device__ __forceinline__ void operator()(const f32x4 (&acc)[2][2][4][2], const Unit& u, int wr, int wc, int fr, int fq) const {
        const int col0 = u.pn * BM + wc * 32 + 4 * fq;
#pragma unroll
        for (int m = 0; m < 4; ++m) { const int r = wr * 64 + m * 16 + fr;
#pragma unroll
            for (int bj = 0; bj < 2; ++bj)
#pragma unroll
                for (int n = 0; n < 2; ++n) { float* p = accb + (size_t)r * D + col0 + bj * HALF + n * 16; const f32x4 v = acc[0][bj][m][n];
#pragma unroll
                    for (int j = 0; j < 4; ++j) unsafeAtomicAdd(p + j, v[j]); } }
    }
};
struct EpiMerged { static constexpr bool HAS_MID = true, PERM = false, AFTER_DRAIN = false; const bf16_t* proj; bf16_t* merged;
    __device__ __forceinline__ void mid(f32x4 (&acc)[2][2][4][2], const Unit& u, int wr, int wc, int fr, int fq) const {
        int row0 = u.pm * BM + wr * 64 + fr, col0 = u.pn * BM + wc * 32 + 4 * fq;
        asm volatile("" : "+v"(row0), "+v"(col0));
#pragma unroll
        for (int ai = 0; ai < 2; ++ai)
#pragma unroll
            for (int m = 0; m < 4; ++m) { const bf16_t* pr = proj + (size_t)(row0 + ai * HALF + m * 16) * NINP + col0;
#pragma unroll
                for (int bj = 0; bj < 2; ++bj)
#pragma unroll
                    for (int n = 0; n < 2; ++n) { const u32x2 ga = *(const u32x2*)(pr + C_GA + bj * HALF + n * 16), gb = *(const u32x2*)(pr + C_GB + bj * HALF + n * 16);
                        f32x4 r;
                        r[0] = (1.0f + __expf(-lo_bf(gb.x))) * __builtin_amdgcn_rcpf(1.0f + __expf(-lo_bf(ga.x))); r[1] = (1.0f + __expf(-hi_bf(gb.x))) * __builtin_amdgcn_rcpf(1.0f + __expf(-hi_bf(ga.x)));
                        r[2] = (1.0f + __expf(-lo_bf(gb.y))) * __builtin_amdgcn_rcpf(1.0f + __expf(-lo_bf(ga.y))); r[3] = (1.0f + __expf(-hi_bf(gb.y))) * __builtin_amdgcn_rcpf(1.0f + __expf(-hi_bf(ga.y)));
                        acc[ai][bj][m][n] *= r; } }
        asm volatile("s_waitcnt vmcnt(0)" ::: "memory");
    }
    __device__ __forceinline__ void operator()(const f32x4 (&acc)[2][2][4][2], const Unit& u, int wr, int wc, int fr, int fq) const {
        const int row0 = u.pm * BM + wr * 64 + fr, col0 = u.pn * BM + wc * 32 + 4 * fq;
#pragma unroll
        for (int ai = 0; ai < 2; ++ai)
#pragma unroll
            for (int m = 0; m < 4; ++m) { const int row = row0 + ai * HALF + m * 16; const bf16_t* pr = proj + (size_t)row * NINP + C_GB + col0;
#pragma unroll
                for (int bj = 0; bj < 2; ++bj)
#pragma unroll
                    for (int n = 0; n < 2; ++n) { const u32x2 gb = *(const u32x2*)(pr + bj * HALF + n * 16); const f32x4 v = acc[ai][bj][m][n]; u32x2 w;
                        w.x = cvt_pk_bf16(v[0] * sigmoidf_(lo_bf(gb.x)), v[1] * sigmoidf_(hi_bf(gb.x))); w.y = cvt_pk_bf16(v[2] * sigmoidf_(lo_bf(gb.y)), v[3] * sigmoidf_(hi_bf(gb.y)));
                        *(u32x2*)(merged + (size_t)row * D + col0 + bj * HALF + n * 16) = w; } }
    }
};
template <int WHICH> struct EpiRes { static constexpr bool HAS_MID = false, PERM = false, AFTER_DRAIN = false; const float* xp; const float* ada; bf16_t* xb; float* dst;
    __device__ __forceinline__ void operator()(const f32x4 (&acc)[2][2][4][2], const Unit& u, int wr, int wc, int fr, int fq) const {
        const int row0 = u.pm * BM + wr * 64 + fr, col0 = u.pn * BM + wc * 32 + 4 * fq;
#pragma unroll
        for (int ai = 0; ai < 2; ++ai)
#pragma unroll
            for (int m = 0; m < 4; ++m) { const int row = row0 + ai * HALF + m * 16;
                const float* g = ada + (size_t)(row >> 11) * NADA + (WHICH == 0 ? 2 * D : 5 * D);
#pragma unroll
                for (int bj = 0; bj < 2; ++bj)
#pragma unroll
                    for (int n = 0; n < 2; ++n) { const int col = col0 + bj * HALF + n * 16; const f32x4 gv = *(const f32x4*)(g + col);
                        if (WHICH == 0) { const f32x4 o = *(const f32x4*)(xp + (size_t)row * D + col) * ALPHA + gv * acc[ai][bj][m][n];
                            u32x2 w; w.x = cvt_pk_bf16(o[0], o[1]); w.y = cvt_pk_bf16(o[2], o[3]); *(u32x2*)(xb + (size_t)row * D + col) = w; }
                        else { const u32x2 xw = *(const u32x2*)(xb + (size_t)row * D + col); const f32x4 bv = {lo_bf(xw.x), hi_bf(xw.x), lo_bf(xw.y), hi_bf(xw.y)};
                            *(f32x4*)(dst + (size_t)row * D + col) = bv * ALPHA + gv * acc[ai][bj][m][n]; } } }
    }
};

__device__ __forceinline__ bf16x8 ldfrag(const bf16_t* base, int row, int stride, int k) { return *(const bf16x8*)(base + row * stride + k); }
#define MFMA16(x, y, c) __builtin_amdgcn_mfma_f32_16x16x32_bf16((x), (y), (c), 0, 0, 0)

typedef float f32x2v __attribute__((ext_vector_type(2)));

static __device__ __forceinline__ void ret_prompt_item(const Params& P, int b, int h, unsigned char* smem) {
    const int tid = threadIdx.x, lane = tid & 63, wave = tid >> 6, fr = lane & 15, fq = lane >> 4;
    bf16_t* Qs = (bf16_t*)smem;
    bf16_t* Ks = Qs + 64 * 136;
    bf16_t* Kdt = Ks + 64 * 136;
    bf16_t* Vt = Kdt + 128 * 72;
    bf16_t* Ps = Vt + 128 * 72;
    bf16_t* St = Ps + 64 * 72;
    float* gpow = (float*)(St + 128 * 136);
    const bf16_t* proj = (const bf16_t*)(P.ws + WS_RA);
    const float* cosT = (const float*)(P.ws + WS_ROPE); const float* sinT = cosT + 2049 * 64;
    bf16_t* oret = (bf16_t*)P.out;
    const float log_g = log1pf(-exp2f(-5.0f - (float)h));
    if (tid < 80) gpow[tid] = expf(log_g * (float)tid);
    for (int i = tid; i < 128 * 136 / 2; i += 512) ((unsigned*)St)[i] = 0u;
    f32x4 S[8];
#pragma unroll
    for (int i = 0; i < 8; ++i) S[i] = (f32x4){0.f, 0.f, 0.f, 0.f};
    __syncthreads();
    const int j = tid >> 3, dg = tid & 7;
    u32x4 q1, q2, k1, k2, v1, v2; f32x4 c0, c1, s0, s1;
#define RET_LOAD(c) do { const int pos = (c) * 64 + j; const bf16_t* pr = proj + ((size_t)b * SEQ + pos) * NINP + h * 128; \
        q1 = *(const u32x4*)(pr + C_Q + dg * 8); q2 = *(const u32x4*)(pr + C_Q + 64 + dg * 8); k1 = *(const u32x4*)(pr + C_K + dg * 8); k2 = *(const u32x4*)(pr + C_K + 64 + dg * 8); \
        v1 = *(const u32x4*)(pr + C_V + dg * 16); v2 = *(const u32x4*)(pr + C_V + dg * 16 + 8); \
        c0 = *(const f32x4*)(cosT + pos * 64 + dg * 8); c1 = *(const f32x4*)(cosT + pos * 64 + dg * 8 + 4); s0 = *(const f32x4*)(sinT + pos * 64 + dg * 8); s1 = *(const f32x4*)(sinT + pos * 64 + dg * 8 + 4); } while (0)
    RET_LOAD(0);
    for (int c = 0; c < SEQ / 64; ++c) {
        {
            float cs[8] = {c0[0], c0[1], c0[2], c0[3], c1[0], c1[1], c1[2], c1[3]}, sn[8] = {s0[0], s0[1], s0[2], s0[3], s1[0], s1[1], s1[2], s1[3]};
            const unsigned qa[4] = {q1.x, q1.y, q1.z, q1.w}, qb[4] = {q2.x, q2.y, q2.z, q2.w}, ka[4] = {k1.x, k1.y, k1.z, k1.w}, kb[4] = {k2.x, k2.y, k2.z, k2.w};
            float qo1[8], qo2[8], ko1[8], ko2[8];
#pragma unroll
            for (int e = 0; e < 4; ++e) {
#pragma unroll
                for (int hh = 0; hh < 2; ++hh) { const int i = e * 2 + hh;
                    const float a1 = hh ? hi_bf(qa[e]) : lo_bf(qa[e]), a2 = hh ? hi_bf(qb[e]) : lo_bf(qb[e]);
                    const float b1 = hh ? hi_bf(ka[e]) : lo_bf(ka[e]), b2 = hh ? hi_bf(kb[e]) : lo_bf(kb[e]);
                    qo1[i] = a1 * cs[i] - a2 * sn[i]; qo2[i] = a1 * sn[i] + a2 * cs[i];
                    ko1[i] = (b1 * cs[i] - b2 * sn[i]) * 0.08838834764831845f; ko2[i] = (b1 * sn[i] + b2 * cs[i]) * 0.08838834764831845f; } }
            u32x4 w;
            w.x = cvt_pk_bf16(qo1[0], qo1[1]); w.y = cvt_pk_bf16(qo1[2], qo1[3]); w.z = cvt_pk_bf16(qo1[4], qo1[5]); w.w = cvt_pk_bf16(qo1[6], qo1[7]); *(u32x4*)(Qs + j * 136 + dg * 8) = w;
            w.x = cvt_pk_bf16(qo2[0], qo2[1]); w.y = cvt_pk_bf16(qo2[2], qo2[3]); w.z = cvt_pk_bf16(qo2[4], qo2[5]); w.w = cvt_pk_bf16(qo2[6], qo2[7]); *(u32x4*)(Qs + j * 136 + 64 + dg * 8) = w;
            w.x = cvt_pk_bf16(ko1[0], ko1[1]); w.y = cvt_pk_bf16(ko1[2], ko1[3]); w.z = cvt_pk_bf16(ko1[4], ko1[5]); w.w = cvt_pk_bf16(ko1[6], ko1[7]); *(u32x4*)(Ks + j * 136 + dg * 8) = w;
            w.x = cvt_pk_bf16(ko2[0], ko2[1]); w.y = cvt_pk_bf16(ko2[2], ko2[3]); w.z = cvt_pk_bf16(ko2[4], ko2[5]); w.w = cvt_pk_bf16(ko2[6], ko2[7]); *(u32x4*)(Ks + j * 136 + 64 + dg * 8) = w;
            const float kd = gpow[63 - j];
#pragma unroll
            for (int i = 0; i < 8; ++i) { Kdt[(dg * 8 + i) * 72 + j] = f2bf(ko1[i] * kd); Kdt[(64 + dg * 8 + i) * 72 + j] = f2bf(ko2[i] * kd); }
            const unsigned va[8] = {v1.x, v1.y, v1.z, v1.w, v2.x, v2.y, v2.z, v2.w};
#pragma unroll
            for (int e = 0; e < 8; ++e) { Vt[(dg * 16 + 2 * e) * 72 + j] = (bf16_t)(va[e] & 0xffffu); Vt[(dg * 16 + 2 * e + 1) * 72 + j] = (bf16_t)(va[e] >> 16); }
        }
        RW_BAR();
        if (c + 1 < SEQ / 64) RET_LOAD(c + 1);
        f32x4 O[4];
#pragma unroll
        for (int it = 0; it < 4; ++it) O[it] = (f32x4){0.f, 0.f, 0.f, 0.f};
#pragma unroll
        for (int ks = 0; ks < 4; ++ks) { const bf16x8 yf = ldfrag(St, wave * 16 + fr, 136, ks * 32 + fq * 8);
#pragma unroll
            for (int it = 0; it < 4; ++it) O[it] = MFMA16(ldfrag(Qs, it * 16 + fr, 136, ks * 32 + fq * 8), yf, O[it]); }
#pragma unroll
        for (int it = 0; it < 4; ++it)
#pragma unroll
            for (int jj = 0; jj < 4; ++jj) O[it][jj] *= gpow[it * 16 + fq * 4 + jj + 1];
        { const int it = wave >> 1;
#pragma unroll
            for (int j2 = 0; j2 < 2; ++j2) { const int jt = (wave & 1) * 2 + j2; f32x4 a = (f32x4){0.f, 0.f, 0.f, 0.f};
#pragma unroll
                for (int ks = 0; ks < 4; ++ks) a = MFMA16(ldfrag(Qs, it * 16 + fr, 136, ks * 32 + fq * 8), ldfrag(Ks, jt * 16 + fr, 136, ks * 32 + fq * 8), a);
#pragma unroll
                for (int jj = 0; jj < 4; ++jj) { const int i = it * 16 + fq * 4 + jj, jc = jt * 16 + fr; const int dd = i - jc;
                    const float pv = dd >= 0 ? a[jj] * gpow[dd >= 0 ? dd : 0] : 0.f; Ps[i * 72 + jc] = f2bf(pv); } } }
        RW_BAR();
#pragma unroll
        for (int ks = 0; ks < 2; ++ks) { const bf16x8 yf = ldfrag(Vt, wave * 16 + fr, 72, ks * 32 + fq * 8);
#pragma unroll
            for (int it = 0; it < 4; ++it) O[it] = MFMA16(ldfrag(Ps, it * 16 + fr, 72, ks * 32 + fq * 8), yf, O[it]); }
#pragma unroll
        for (int it = 0; it < 4; ++it)
#pragma unroll
            for (int jj = 0; jj < 4; ++jj) { const int i = it * 16 + fq * 4 + jj; oret[((size_t)b * SEQ + c * 64 + i) * RW + h * 128 + wave * 16 + fr] = f2bf(O[it][jj]); }
        { const float bd = gpow[64];
#pragma unroll
            for (int dt = 0; dt < 8; ++dt) S[dt] *= bd;
#pragma unroll
            for (int ks = 0; ks < 2; ++ks) { const bf16x8 yf = ldfrag(Vt, wave * 16 + fr, 72, ks * 32 + fq * 8);
#pragma unroll
                for (int dt = 0; dt < 8; ++dt) S[dt] = MFMA16(ldfrag(Kdt, dt * 16 + fr, 72, ks * 32 + fq * 8), yf, S[dt]); } }
        RW_BAR();
#pragma unroll
        for (int dt = 0; dt < 8; ++dt) { u32x2 w; w.x = cvt_pk_bf16(S[dt][0], S[dt][1]); w.y = cvt_pk_bf16(S[dt][2], S[dt][3]); *(u32x2*)(St + (wave * 16 + fr) * 136 + dt * 16 + fq * 4) = w; }
    }
    float* so = P.out + O_RETP + (size_t)(b * 8 + h) * 128 * 128;
#pragma unroll
    for (int dt = 0; dt < 8; ++dt)
#pragma unroll
        for (int jj = 0; jj < 4; ++jj) so[(dt * 16 + fq * 4 + jj) * 128 + wave * 16 + fr] = S[dt][jj];
    __syncthreads();
}

static __device__ __forceinline__ void ret_sample_pair(const Params& P, int pair, unsigned char* smem) {
    const int tid = threadIdx.x, lane = tid & 63;
    float* qs = (float*)smem; float* ks = qs + 128; float* red = ks + 128;
    const int i = pair >> 3, h = pair & 7; const size_t row = (size_t)MPR + i;
    const bf16_t* pr = (const bf16_t*)(P.ws + WS_RA) + row * NINP + h * 128;
    const float* cosT = (const float*)(P.ws + WS_ROPE) + 2048 * 64; const float* sinT = cosT + 2049 * 64;
    const int c4 = (tid & 31) * 4, g = tid >> 5;
    const float* S0 = P.in[I_SRET] + (size_t)pair * 128 * 128 + (size_t)(g * 8) * 128 + c4; float* So = P.out + O_RETS + (size_t)pair * 128 * 128 + (size_t)(g * 8) * 128 + c4;
    f32x4 sv[8];
#pragma unroll
    for (int e = 0; e < 8; ++e) sv[e] = __builtin_nontemporal_load((const f32x4*)(S0 + e * 128));
    const u32x2 vw = *(const u32x2*)(pr + C_V + c4); const f32x4 vv = {lo_bf(vw.x), hi_bf(vw.x), lo_bf(vw.y), hi_bf(vw.y)};
    if (tid < 64) { const float cc = cosT[tid], ss = sinT[tid];
        const float a1 = bf2f(pr[C_Q + tid]), a2 = bf2f(pr[C_Q + 64 + tid]), b1 = bf2f(pr[C_K + tid]), b2 = bf2f(pr[C_K + 64 + tid]);
        qs[tid] = a1 * cc - a2 * ss; qs[64 + tid] = a1 * ss + a2 * cc;
        ks[tid] = (b1 * cc - b2 * ss) * 0.08838834764831845f; ks[64 + tid] = (b1 * ss + b2 * cc) * 0.08838834764831845f; }
    __syncthreads();
    const float qk = wave_sum(qs[lane] * ks[lane] + qs[64 + lane] * ks[64 + lane]);
    const float gam = 1.0f - exp2f(-5.0f - (float)h);
    f32x4 acc = {0.f, 0.f, 0.f, 0.f};
#pragma unroll
    for (int e = 0; e < 8; ++e) { const float q = qs[g * 8 + e], k = ks[g * 8 + e]; acc += sv[e] * q; __builtin_nontemporal_store(sv[e] * gam + vv * k, (f32x4*)(So + e * 128)); }
    *(f32x4*)(red + g * 128 + c4) = acc;
    __syncthreads();
    if (tid < 128) { float t = 0.f;
#pragma unroll
        for (int e = 0; e < 16; ++e) t += red[e * 128 + tid];
        ((bf16_t*)P.out)[row * RW + h * 128 + tid] = f2bf(qk * bf2f(pr[C_V + tid]) + gam * t); }
    __syncthreads();
}

__device__ __forceinline__ float fma_s(float a, float b, float c) { float d; asm("v_fma_f32 %0, %1, %2, %3" : "=v"(d) : "v"(a), "v"(b), "v"(c)); return d; }
__device__ __forceinline__ float fnma_s(float a, float b, float c) { float d; asm("v_fma_f32 %0, -%1, %2, %3" : "=v"(d) : "v"(a), "v"(b), "v"(c)); return d; }
__device__ __forceinline__ float mul_s(float a, float b) { float d; asm("v_mul_f32 %0, %1, %2" : "=v"(d) : "v"(a), "v"(b)); return d; }
static __device__ __forceinline__ void rwkv_prompt_item(const Params& P, int item, unsigned char* smem) {
    const int tid = threadIdx.x, lane = tid & 63, wave = tid >> 6;
    const int bh = item >> 1, half = item & 1, b = bh >> 4, h = bh & 15;
    float* BUF = (float*)smem;
    float* OOb = BUF + 2 * 12288;
    const bf16_t* proj = (const bf16_t*)(P.ws + WS_RA);
    const float* decA = (const float*)(P.ws + WS_RB); const float* aaA = decA + (size_t)MP * RW;
    bf16_t* oraw = (bf16_t*)(P.ws + WS_RC); float* bonus = (float*)(P.ws + WS_BONUS);
    const int col = h * 64 + lane;
    const size_t rowb = (size_t)b * SEQ;
    constexpr int NCH = SEQ / 32;
    if (wave >= 4) {
        const int pw = wave - 4, ptid = tid - 256;
        const float mu_r = P.in[I_MU][col], mu_k = P.in[I_MU][RW + col], mu_v = P.in[I_MU][2 * RW + col];
        const float kk_c = P.in[I_KK][col], ka_c = P.in[I_KA][col], rk_c = P.in[I_RK][col];
        float zr[9], zk[9], zv[9], av[8], dcv[8];
#define RWKV_LOAD(c) do { const int t0 = (c) * 32 + pw * 8; \
        _Pragma("unroll") for (int e = 0; e < 9; ++e) { const int t = t0 + e - 1; \
            if (t >= 0) { const bf16_t* pz = proj + (rowb + t) * NINP + col; zr[e] = bf2f(pz[0]); zk[e] = bf2f(pz[RW]); zv[e] = bf2f(pz[2 * RW]); } else { zr[e] = 0.f; zk[e] = 0.f; zv[e] = 0.f; } } \
        _Pragma("unroll") for (int e = 0; e < 8; ++e) { av[e] = aaA[(rowb + t0 + e) * RW + col]; dcv[e] = decA[(rowb + t0 + e) * RW + col]; } } while (0)
#define RWKV_STAGE(c) do { float* kb = BUF + ((c) & 1) * 12288; \
        _Pragma("unroll") for (int e = 0; e < 8; ++e) { const int tt = pw * 8 + e; \
            const float r = zr[e + 1] + mu_r * (zr[e] - zr[e + 1]), k = zk[e + 1] + mu_k * (zk[e] - zk[e + 1]), v = zv[e + 1] + mu_v * (zv[e] - zv[e + 1]); \
            const float kkv = k * kk_c; const float nrm = sqrtf(wave_sum(kkv * kkv)); const float kkn = kkv / fmaxf(nrm, 1e-12f); \
            const float a = av[e]; const float kx = k * (1.0f + (a - 1.0f) * ka_c); \
            const float bo = wave_sum(r * kx * rk_c); \
            kb[tt * 64 + lane] = kkn; kb[2048 + tt * 64 + lane] = dcv[e]; kb[4096 + tt * 64 + lane] = kkn * a; kb[6144 + tt * 64 + lane] = kx; kb[8192 + tt * 64 + lane] = r; kb[10240 + tt * 64 + lane] = v; \
            if (half == 0 && lane == 0) bonus[(rowb + (c) * 32 + tt) * 16 + h] = bo; } } while (0)
#define RWKV_OWRITE(c) do { const float* oo = OOb + ((c) & 1) * 1024; \
        _Pragma("unroll") for (int k2 = 0; k2 < 4; ++k2) { const int idx = ptid + k2 * 256, tt = idx >> 5, i = idx & 31; oraw[(rowb + (c) * 32 + tt) * RW + h * 64 + half * 32 + i] = f2bf(oo[idx]); } } while (0)
        RWKV_LOAD(0); RWKV_STAGE(0); RWKV_LOAD(1);
        RW_BAR();
        for (int c = 0; c < NCH; ++c) {
            if (c + 1 < NCH) { RWKV_STAGE(c + 1); if (c + 2 < NCH) RWKV_LOAD(c + 2); }
            if (c >= 1) RWKV_OWRITE(c - 1);
            RW_BAR();
        }
        RWKV_OWRITE(NCH - 1);
#undef RWKV_LOAD
#undef RWKV_STAGE
#undef RWKV_OWRITE
    } else {
        const int rr = lane >> 3, s = lane & 7, r32 = wave * 8 + rr;
        f32x2v S01 = {0.f, 0.f}, S23 = {0.f, 0.f}, S45 = {0.f, 0.f}, S67 = {0.f, 0.f};
        RW_BAR();
        for (int c = 0; c < NCH; ++c) {
            const float* kb = BUF + (c & 1) * 12288 + s * 8;
            const float* vb = BUF + (c & 1) * 12288 + 10240 + half * 32 + r32;
            float ok0 = 0.f, ok1 = 0.f, ok2 = 0.f, ok3 = 0.f, qprev = 0.f;
            f32x4 kka = *(const f32x4*)(kb), kkb = *(const f32x4*)(kb + 4), wa = *(const f32x4*)(kb + 2048), wb = *(const f32x4*)(kb + 2052), ba = *(const f32x4*)(kb + 4096), bb_ = *(const f32x4*)(kb + 4100);
            f32x4 kxa = *(const f32x4*)(kb + 6144), kxb = *(const f32x4*)(kb + 6148), ra = *(const f32x4*)(kb + 8192), rb = *(const f32x4*)(kb + 8196); float vn = vb[0];
#pragma unroll
            for (int tt = 0; tt < 32; ++tt) {
                const f32x4 k0 = kka, k1 = kkb, w0 = wa, w1 = wb, b0 = ba, b1 = bb_, x0 = kxa, x1 = kxb, r0 = ra, r1 = rb; const float vA = vn;
                if (tt + 1 < 32) { const float* kq = kb + (tt + 1) * 64; kka = *(const f32x4*)(kq); kkb = *(const f32x4*)(kq + 4); wa = *(const f32x4*)(kq + 2048); wb = *(const f32x4*)(kq + 2052); ba = *(const f32x4*)(kq + 4096); bb_ = *(const f32x4*)(kq + 4100);
                    kxa = *(const f32x4*)(kq + 6144); kxb = *(const f32x4*)(kq + 6148); ra = *(const f32x4*)(kq + 8192); rb = *(const f32x4*)(kq + 8196); vn = vb[(tt + 1) * 64]; }
                __builtin_amdgcn_sched_barrier(0);
                f32x2v pp = S01 * (f32x2v){k0[0], k0[1]}; pp = S23 * (f32x2v){k0[2], k0[3]} + pp; pp = S45 * (f32x2v){k1[0], k1[1]} + pp; pp = S67 * (f32x2v){k1[2], k1[3]} + pp;
                float p = pp.x + pp.y;
                f32x2v u01 = (f32x2v){x0[0], x0[1]} * vA, u23 = (f32x2v){x0[2], x0[3]} * vA, u45 = (f32x2v){x1[0], x1[1]} * vA, u67 = (f32x2v){x1[2], x1[3]} * vA;
                if (tt > 0) {
                    float q = qprev; q += dpp_f<0xB1>(q); q += dpp_f<0x4E>(q); q += dpp_f<0x141>(q);
                    const int tp = tt - 1;
                    if (s == (tp & 7)) { if ((tp >> 3) == 0) ok0 = q; else if ((tp >> 3) == 1) ok1 = q; else if ((tp >> 3) == 2) ok2 = q; else ok3 = q; } }
                p += dpp_f<0xB1>(p); p += dpp_f<0x4E>(p); p += dpp_f<0x141>(p);
                u01 = u01 - (f32x2v){b0[0], b0[1]} * p; u23 = u23 - (f32x2v){b0[2], b0[3]} * p; u45 = u45 - (f32x2v){b1[0], b1[1]} * p; u67 = u67 - (f32x2v){b1[2], b1[3]} * p;
                S01 = S01 * (f32x2v){w0[0], w0[1]} + u01; S23 = S23 * (f32x2v){w0[2], w0[3]} + u23; S45 = S45 * (f32x2v){w1[0], w1[1]} + u45; S67 = S67 * (f32x2v){w1[2], w1[3]} + u67;
                f32x2v qq = S01 * (f32x2v){r0[0], r0[1]}; qq = S23 * (f32x2v){r0[2], r0[3]} + qq; qq = S45 * (f32x2v){r1[0], r1[1]} + qq; qq = S67 * (f32x2v){r1[2], r1[3]} + qq;
                qprev = qq.x + qq.y;
            }
            { float q = qprev; q += dpp_f<0xB1>(q); q += dpp_f<0x4E>(q); q += dpp_f<0x141>(q); if (s == 7) ok3 = q; }
            float* oo = OOb + (c & 1) * 1024;
            oo[s * 32 + r32] = ok0; oo[(8 + s) * 32 + r32] = ok1; oo[(16 + s) * 32 + r32] = ok2; oo[(24 + s) * 32 + r32] = ok3;
            RW_BAR();
        }
        float* so = P.out + O_WKVP + ((size_t)(b * 16 + h) * 64 + half * 32 + r32) * 64 + s * 8;
        { f32x4 o = {S01.x, S01.y, S23.x, S23.y}; *(f32x4*)(so) = o; }
        { f32x4 o = {S45.x, S45.y, S67.x, S67.y}; *(f32x4*)(so + 4) = o; }
    }
    __syncthreads();
}

static __device__ __forceinline__ void rwkv_sample_pair(const Params& P, int pair) {
    const int lane = threadIdx.x & 63; const int i = pair >> 4, h = pair & 15; const size_t row = (size_t)MPR + i; const int col = h * 64 + lane;
    const bf16_t* pz = (const bf16_t*)(P.ws + WS_RA) + row * NINP + col;
    const float* sp = P.in[I_SSHIFT] + (size_t)i * PRW + col;
    const float zr = bf2f(pz[0]), zk = bf2f(pz[RW]), zv = bf2f(pz[2 * RW]);
    const float r = zr + P.in[I_MU][col] * (sp[0] - zr), k = zk + P.in[I_MU][RW + col] * (sp[RW] - zk), v = zv + P.in[I_MU][2 * RW + col] * (sp[2 * RW] - zv);
    const float* decA = (const float*)(P.ws + WS_RB); const float* aaA = decA + (size_t)MP * RW;
    const float a = aaA[row * RW + col], dec = decA[row * RW + col];
    const float kkv = k * P.in[I_KK][col]; const float nrm = sqrtf(wave_sum(kkv * kkv)); const float kkn = kkv / fmaxf(nrm, 1e-12f);
    const float kx = k * (1.0f + (a - 1.0f) * P.in[I_KA][col]); const float bb = kkn * a;
    const float bo = wave_sum(r * kx * P.in[I_RK][col]);
    if (lane == 0) ((float*)(P.ws + WS_BONUS))[row * 16 + h] = bo;
    const float* S0 = P.in[I_SWKV] + (size_t)pair * 4096; float* So = P.out + O_WKVS + (size_t)pair * 4096;
    float omine = 0.f;
#pragma unroll 1
    for (int vb = 0; vb < 64; vb += 16) { float svv[16];
#pragma unroll
    for (int e = 0; e < 16; ++e) svv[e] = __builtin_nontemporal_load(S0 + (vb + e) * 64 + lane);
#pragma unroll
    for (int e = 0; e < 16; ++e) { const int vr = vb + e; const float sv = svv[e]; const float sa = -wave_sum(sv * kkn); const float vv = __shfl(v, vr);
        const float sn = sv * dec + sa * bb + vv * kx; __builtin_nontemporal_store(sn, So + vr * 64 + lane); const float o = wave_sum(sn * r); if (lane == vr) omine = o; } }
    ((bf16_t*)(P.ws + WS_RC))[row * RW + col] = f2bf(omine);
}

__device__ __forceinline__ void unpack8(const u32x4 t, float (&o)[8]) { o[0] = lo_bf(t.x); o[1] = hi_bf(t.x); o[2] = lo_bf(t.y); o[3] = hi_bf(t.y); o[4] = lo_bf(t.z); o[5] = hi_bf(t.z); o[6] = lo_bf(t.w); o[7] = hi_bf(t.w); }
static __device__ __forceinline__ void phase_misc0(const Params& P) {
    const size_t gtid = (size_t)blockIdx.x * 512 + threadIdx.x, gsz = (size_t)gridDim.x * 512;
    bf16_t* aada = (bf16_t*)(P.ws + WS_AADA);
    for (size_t i = gtid; i < (size_t)256 * D; i += gsz) { const int r = (int)(i / D), c = (int)(i % D);
        const float v = r < NB ? P.in[I_CP][r * D + c] : (r < NB + NS ? P.in[I_CS][(r - NB) * D + c] : 0.f); aada[i] = f2bf(v); }
    float* cosT = (float*)(P.ws + WS_ROPE); float* sinT = cosT + 2049 * 64;
    for (size_t i = gtid; i < (size_t)2049 * 64; i += gsz) { const int pi = (int)(i >> 6), jx = (int)(i & 63);
        const double pos = pi == 2048 ? 16384.0 : (double)pi;
        const float inv = (float)exp(-((double)jx / 64.0) * 9.210340371976184);
        const double ang = pos * (double)inv;
        const double n = rint(ang * 0.15915494309189535); const double rr = ang - n * 6.283185307179586;
        const double r2 = rr * rr; double ts = rr, tc = 1.0, sv = rr, cv = 1.0;
#pragma unroll 1
        for (int k = 1; k <= 13; ++k) { tc *= -r2 / (double)((2 * k - 1) * (2 * k)); ts *= -r2 / (double)((2 * k) * (2 * k + 1)); cv += tc; sv += ts; }
        cosT[i] = (float)cv; sinT[i] = (float)sv; }
}
static __device__ __forceinline__ void phase_misc1(const Params& P, size_t gtid, size_t gsz) {
    unsigned* z = (unsigned*)((bf16_t*)(P.ws + WS_WIN) + (size_t)PRW * D);
    for (size_t i = gtid; i < (size_t)(C_Q - PRW) * D / 2; i += gsz) z[i] = 0u;
    bf16_t* bl = (bf16_t*)(P.ws + WS_WLORA);
    for (size_t i = gtid; i < (size_t)NL * KL; i += gsz) { const int n = (int)(i / KL), k = (int)(i % KL); float v = 0.f;
        if (n < 1024) { if (k < 64) v = P.in[I_WDEC][k * RW + n]; }
        else if (n < 2048) { if (k >= 64 && k < 128) v = P.in[I_WAAA][(k - 64) * RW + (n - 1024)]; }
        else { if (k >= 128 && k < 288) v = P.in[I_WGATE][(k - 128) * RW + (n - 2048)]; }
        bl[i] = f2bf(v); }
}
static __device__ __forceinline__ void phase_modulate(const Params& P) {
    const float* ada = (const float*)(P.ws + WS_ADA); bf16_t* u = (bf16_t*)(P.ws + WS_RC);
    for (size_t i = (size_t)blockIdx.x * 512 + threadIdx.x; i < (size_t)MP * (D / 8); i += (size_t)gridDim.x * 512) {
        const int row = (int)(i >> 8), c = (int)(i & 255) * 8; u32x4 w = {0u, 0u, 0u, 0u};
        if (row < MTOK) { const float* x = row < MPR ? P.in[I_XP] + (size_t)row * D : P.in[I_XS] + (size_t)(row - MPR) * D; const float* ar = ada + (size_t)ada_row(row) * NADA;
            const f32x4 x0 = __builtin_nontemporal_load((const f32x4*)(x + c)), x1 = __builtin_nontemporal_load((const f32x4*)(x + c + 4)), h0 = *(const f32x4*)(ar + c), h1 = *(const f32x4*)(ar + c + 4), s0 = *(const f32x4*)(ar + D + c), s1 = *(const f32x4*)(ar + D + c + 4);
            const f32x4 a = x0 * (s0 + 1.0f) + h0, b = x1 * (s1 + 1.0f) + h1;
            w.x = cvt_pk_bf16(a[0], a[1]); w.y = cvt_pk_bf16(a[2], a[3]); w.z = cvt_pk_bf16(b[0], b[1]); w.w = cvt_pk_bf16(b[2], b[3]); }
        *(u32x4*)(u + (size_t)row * D + c) = w; }
}
static __device__ __forceinline__ void phase_lora_in(const Params& P) {
    const bf16_t* proj = (const bf16_t*)(P.ws + WS_RA); bf16_t* al = (bf16_t*)(P.ws + WS_ALORA);
    const size_t gtid = (size_t)blockIdx.x * 512 + threadIdx.x, gsz = (size_t)gridDim.x * 512;
    for (size_t i = gtid; i < (size_t)MP * (KL / 8); i += gsz) { const int row = (int)(i / (KL / 8)), k = (int)(i % (KL / 8)) * 8; u32x4 w = {0u, 0u, 0u, 0u};
        if (row < MTOK && k < 288) { const int c = 3072 + k; float z[8], pv[8], o[8];
            unpack8(*(const u32x4*)(proj + (size_t)row * NINP + c), z);
            if (row < MPR) { u32x4 t1 = {0u, 0u, 0u, 0u}; if ((row & (SEQ - 1)) != 0) t1 = *(const u32x4*)(proj + (size_t)(row - 1) * NINP + c); unpack8(t1, pv); }
            else { const float* sp = P.in[I_SSHIFT] + (size_t)(row - MPR) * PRW + c;
#pragma unroll
                for (int e = 0; e < 8; ++e) pv[e] = sp[e]; }
#pragma unroll
            for (int e = 0; e < 8; ++e) { const float zs = z[e] + P.in[I_MU][c + e] * (pv[e] - z[e]); o[e] = k < 64 ? tanhf(zs) : (k < 128 ? zs : sigmoidf_(zs)); }
            w.x = cvt_pk_bf16(o[0], o[1]); w.y = cvt_pk_bf16(o[2], o[3]); w.z = cvt_pk_bf16(o[4], o[5]); w.w = cvt_pk_bf16(o[6], o[7]); }
        *(u32x4*)(al + (size_t)row * KL + k) = w; }
    for (size_t i = gtid; i < (size_t)(NB + NS) * PRW; i += gsz) { const int r = (int)(i / PRW), c = (int)(i % PRW);
        const size_t row = r < NB ? (size_t)r * SEQ + SEQ - 1 : (size_t)MPR + (r - NB);
        const float v = bf2f(proj[row * NINP + c]);
        if (r < NB) P.out[O_SHIFTP + (size_t)r * PRW + c] = v; else P.out[O_SHIFTS + (size_t)(r - NB) * PRW + c] = v; }
}
static __device__ __forceinline__ void phase_post(const Params& P) {
    const int lane = threadIdx.x & 63, wave = threadIdx.x >> 6;
    const bf16_t* __restrict__ proj = (const bf16_t*)(P.ws + WS_RA); const bf16_t* __restrict__ oraw = (const bf16_t*)(P.ws + WS_RC); const bf16_t* __restrict__ oret = (const bf16_t*)P.out;
    const float* __restrict__ bonus = (const float*)(P.ws + WS_BONUS); const bf16_t* __restrict__ gg = (const bf16_t*)(P.ws + WS_RB + (size_t)2 * MP * RW * 4);
    bf16_t* __restrict__ ya = (bf16_t*)(P.ws + WS_RD); bf16_t* __restrict__ yb = ya + RW;
    const int ca0 = (wave * 2) * 64 + lane, ca1 = ca0 + 64, cb0 = wave * 128 + lane, cb1 = cb0 + 64;
    const float lw0 = P.in[I_LNXW][ca0], lw1 = P.in[I_LNXW][ca1], lb0 = P.in[I_LNXB][ca0], lb1 = P.in[I_LNXB][ca1], mv0 = P.in[I_MU][2 * RW + ca0], mv1 = P.in[I_MU][2 * RW + ca1];
    const float gw0 = P.in[I_RGNW][cb0], gw1 = P.in[I_RGNW][cb1], gb0 = P.in[I_RGNB][cb0], gb1 = P.in[I_RGNB][cb1];
    for (int row0 = blockIdx.x * 8; row0 < MP; row0 += gridDim.x * 8) {
        if (row0 >= MTOK) { for (int i = threadIdx.x; i < 8 * D; i += 512) ya[(size_t)row0 * D + i] = 0; continue; }
        float o0[8], o1[8], z0[8], z1[8], p0[8], p1[8], bn0[8], bn1[8], g0[8], g1[8], r0[8], r1[8], q0[8], q1[8];
#pragma unroll
        for (int e = 0; e < 8; ++e) { const size_t row = (size_t)row0 + e;
            o0[e] = bf2f(__builtin_nontemporal_load(oraw + row * RW + ca0)); o1[e] = bf2f(__builtin_nontemporal_load(oraw + row * RW + ca1));
            z0[e] = bf2f(proj[row * NINP + 2 * RW + ca0]); z1[e] = bf2f(proj[row * NINP + 2 * RW + ca1]);
            if (row < MPR) { const bool first = (row & (SEQ - 1)) == 0; p0[e] = first ? 0.f : bf2f(proj[(row - 1) * NINP + 2 * RW + ca0]); p1[e] = first ? 0.f : bf2f(proj[(row - 1) * NINP + 2 * RW + ca1]); }
            else { p0[e] = P.in[I_SSHIFT][(row - MPR) * PRW + 2 * RW + ca0]; p1[e] = P.in[I_SSHIFT][(row - MPR) * PRW + 2 * RW + ca1]; }
            bn0[e] = bonus[row * 16 + wave * 2]; bn1[e] = bonus[row * 16 + wave * 2 + 1];
            g0[e] = bf2f(gg[row * RW + ca0]); g1[e] = bf2f(gg[row * RW + ca1]);
            r0[e] = bf2f(__builtin_nontemporal_load(oret + row * RW + cb0)); r1[e] = bf2f(__builtin_nontemporal_load(oret + row * RW + cb1));
            q0[e] = bf2f(proj[row * NINP + C_RG + cb0]); q1[e] = bf2f(proj[row * NINP + C_RG + cb1]); }
#pragma unroll
        for (int e = 0; e < 8; ++e) { const size_t row = (size_t)row0 + e;
            { const float mean = wave_sum(o0[e]) * (1.0f / 64.0f); const float d = o0[e] - mean; const float var = wave_sum(d * d) * (1.0f / 64.0f);
              const float v = z0[e] + mv0 * (p0[e] - z0[e]); const float y = (d * rsqrtf(var + 64e-5f) * lw0 + lb0 + bn0[e] * v) * g0[e]; ya[row * D + ca0] = f2bf(y); }
            { const float mean = wave_sum(o1[e]) * (1.0f / 64.0f); const float d = o1[e] - mean; const float var = wave_sum(d * d) * (1.0f / 64.0f);
              const float v = z1[e] + mv1 * (p1[e] - z1[e]); const float y = (d * rsqrtf(var + 64e-5f) * lw1 + lb1 + bn1[e] * v) * g1[e]; ya[row * D + ca1] = f2bf(y); }
            { const float mean = wave_sum(r0[e] + r1[e]) * (1.0f / 128.0f); const float d0 = r0[e] - mean, d1 = r1[e] - mean; const float var = wave_sum(d0 * d0 + d1 * d1) * (1.0f / 128.0f); const float rs = rsqrtf(var + 1e-5f);
              yb[row * D + cb0] = f2bf((d0 * rs * gw0 + gb0) * (q0[e] * sigmoidf_(q0[e]))); yb[row * D + cb1] = f2bf((d1 * rs * gw1 + gb1) * (q1[e] * sigmoidf_(q1[e]))); } }
    }
}
template <int WHICH> static __device__ __forceinline__ void phase_ln(const Params& P) {
    const int lane = threadIdx.x & 63, wave = threadIdx.x >> 6;
    const float* lw = P.in[WHICH == 0 ? I_LN1W : I_LN2W]; const float* lb = P.in[WHICH == 0 ? I_LN1B : I_LN2B];
    const float* ada = (const float*)(P.ws + WS_ADA); bf16_t* u2 = (bf16_t*)(P.ws + WS_RC); bf16_t* xb = (bf16_t*)(P.ws + WS_RD);
    for (int row = blockIdx.x * 8 + wave; row < (WHICH == 0 ? MP : MTOK); row += gridDim.x * 8) {
        if (row >= MTOK) {
#pragma unroll
            for (int j = 0; j < 8; ++j) { u32x2 z = {0u, 0u}; *(u32x2*)(u2 + (size_t)row * D + j * 256 + lane * 4) = z; }
            continue; }
        float* xr = P.out + (size_t)row * D; bf16_t* xbr = xb + (size_t)row * D; f32x4 v[8]; float sm = 0.f;
        const float* ar = ada + (size_t)ada_row(row) * NADA;
        if (row < MPR) {
#pragma unroll
            for (int j = 0; j < 8; ++j) { const int c = j * 256 + lane * 4;
                if (WHICH == 0) { const u32x2 xw = __builtin_nontemporal_load((const u32x2*)(xbr + c)); v[j] = (f32x4){lo_bf(xw.x), hi_bf(xw.x), lo_bf(xw.y), hi_bf(xw.y)}; }
                else v[j] = __builtin_nontemporal_load((const f32x4*)(xr + c)); }
        } else {
            const float* ab = (const float*)(P.ws + WS_ACC) + (size_t)(WHICH == 0 ? 2 : 3) * NS * D + (size_t)(row - MPR) * D; const float* gt = ar + (WHICH == 0 ? 2 * D : 5 * D);
#pragma unroll
            for (int j = 0; j < 8; ++j) { const int c = j * 256 + lane * 4; f32x4 bv;
                if (WHICH == 0) bv = *(const f32x4*)(P.in[I_XS] + (size_t)(row - MPR) * D + c);
                else bv = *(const f32x4*)(xr + c);
                v[j] = bv * ALPHA + *(const f32x4*)(gt + c) * *(const f32x4*)(ab + c); }
        }
#pragma unroll
        for (int j = 0; j < 8; ++j) sm += (v[j][0] + v[j][1]) + (v[j][2] + v[j][3]);
        const float mean = wave_sum(sm) * (1.0f / D); float q = 0.f;
#pragma unroll
        for (int j = 0; j < 8; ++j) { v[j] = v[j] - mean; q += (v[j][0] * v[j][0] + v[j][1] * v[j][1]) + (v[j][2] * v[j][2] + v[j][3] * v[j][3]); }
        const float rs = rsqrtf(wave_sum(q) * (1.0f / D) + 1e-5f);
#pragma unroll
        for (int j = 0; j < 8; ++j) { const int c = j * 256 + lane * 4; const f32x4 y = v[j] * rs * *(const f32x4*)(lw + c) + *(const f32x4*)(lb + c);
            if (WHICH == 0) { u32x2 w1; w1.x = cvt_pk_bf16(y[0], y[1]); w1.y = cvt_pk_bf16(y[2], y[3]); *(u32x2*)(xbr + c) = w1;
                if (row >= MPR) *(f32x4*)(xr + c) = y;
                const f32x4 o = y * (*(const f32x4*)(ar + 4 * D + c) + 1.0f) + *(const f32x4*)(ar + 3 * D + c);
                u32x2 w; w.x = cvt_pk_bf16(o[0], o[1]); w.y = cvt_pk_bf16(o[2], o[3]); *(u32x2*)(u2 + (size_t)row * D + c) = w; }
            else __builtin_nontemporal_store(y, (f32x4*)(xr + c)); }
    }
}
static __device__ __forceinline__ void phase_conv(const Params& P) {
    const bf16_t* __restrict__ hb = (const bf16_t*)(P.ws + WS_RA); bf16_t* __restrict__ g = (bf16_t*)(P.ws + WS_RB);
    const float* __restrict__ cw = P.in[I_CONVW]; const float* __restrict__ cb = P.in[I_CONVB]; const float* __restrict__ sc = P.in[I_SCONV];
    const size_t gtid = (size_t)blockIdx.x * 512 + threadIdx.x, gsz = (size_t)gridDim.x * 512;
    constexpr int RCH = 16, NCG = DFF / 8;
    for (size_t it = gtid; it < (size_t)(MPR / RCH) * NCG; it += gsz) { const int strip = (int)(it / NCG), c = (int)(it % NCG) * 8; const int row0 = strip * RCH, t0 = row0 & (SEQ - 1);
        float w0[2][8], w1[2][8], w2[2][8], bs[2][8], h1[2][8], h2[2][8];
#pragma unroll
        for (int hf = 0; hf < 2; ++hf) { const int cc = c + hf * DFF;
#pragma unroll
            for (int e = 0; e < 8; e += 4) { const f32x4 a = *(const f32x4*)(cw + cc + e), b2 = *(const f32x4*)(cw + F2 + cc + e), d = *(const f32x4*)(cw + 2 * F2 + cc + e), bb = *(const f32x4*)(cb + cc + e);
#pragma unroll
                for (int j = 0; j < 4; ++j) { w0[hf][e + j] = a[j]; w1[hf][e + j] = b2[j]; w2[hf][e + j] = d[j]; bs[hf][e + j] = bb[j]; } }
            u32x4 t1 = {0u, 0u, 0u, 0u}, t2 = {0u, 0u, 0u, 0u};
            if (t0 >= 1) t1 = *(const u32x4*)(hb + (size_t)(row0 - 1) * F2 + cc);
            if (t0 >= 2) t2 = *(const u32x4*)(hb + (size_t)(row0 - 2) * F2 + cc);
            unpack8(t1, h1[hf]); unpack8(t2, h2[hf]); }
#pragma unroll 4
        for (int r = 0; r < RCH; ++r) { const size_t row = (size_t)row0 + r; float y[2][8];
#pragma unroll
            for (int hf = 0; hf < 2; ++hf) { float h0[8]; unpack8(__builtin_nontemporal_load((const u32x4*)(hb + row * F2 + c + hf * DFF)), h0);
#pragma unroll
                for (int e = 0; e < 8; ++e) { y[hf][e] = bs[hf][e] + w0[hf][e] * h2[hf][e] + w1[hf][e] * h1[hf][e] + w2[hf][e] * h0[e]; h2[hf][e] = h1[hf][e]; h1[hf][e] = h0[e]; } }
            u32x4 w; float o[8];
#pragma unroll
            for (int e = 0; e < 8; ++e) o[e] = y[0][e] * sigmoidf_(y[0][e]) * y[1][e];
            w.x = cvt_pk_bf16(o[0], o[1]); w.y = cvt_pk_bf16(o[2], o[3]); w.z = cvt_pk_bf16(o[4], o[5]); w.w = cvt_pk_bf16(o[6], o[7]);
            *(u32x4*)(g + row * DFF + c) = w; }
    }
    for (size_t i = gtid; i < (size_t)(MP - MPR) * NCG; i += gsz) { const int row = MPR + (int)(i / NCG), c = (int)(i % NCG) * 8; u32x4 w = {0u, 0u, 0u, 0u};
        if (row < MTOK) { float y[2][8];
#pragma unroll
            for (int hf = 0; hf < 2; ++hf) { const int cc = c + hf * DFF; float h0[8]; unpack8(*(const u32x4*)(hb + (size_t)row * F2 + cc), h0);
                const float* s0 = sc + ((size_t)(row - MPR) * 2) * F2 + cc; const float* s1 = s0 + F2;
#pragma unroll
                for (int e = 0; e < 8; ++e) y[hf][e] = cb[cc + e] + cw[cc + e] * s0[e] + cw[F2 + cc + e] * s1[e] + cw[2 * F2 + cc + e] * h0[e]; }
            float o[8];
#pragma unroll
            for (int e = 0; e < 8; ++e) o[e] = y[0][e] * sigmoidf_(y[0][e]) * y[1][e];
            w.x = cvt_pk_bf16(o[0], o[1]); w.y = cvt_pk_bf16(o[2], o[3]); w.z = cvt_pk_bf16(o[4], o[5]); w.w = cvt_pk_bf16(o[6], o[7]); }
        *(u32x4*)(g + (size_t)row * DFF + c) = w; }
    for (size_t i = gtid; i < (size_t)NS * F2; i += gsz) { const int r = (int)(i / F2), c = (int)(i % F2); P.out[O_CONVS + ((size_t)r * 2) * F2 + c] = sc[((size_t)r * 2 + 1) * F2 + c]; }
}

struct LoraOrder : pg8::StaticOrder {
    __device__ bool next(int i, Unit& u) const { const bool r = pg8::StaticOrder::next(i, u); if (r) u.k0 = (u.pn >= 8) ? 128 : 0; return r; }
};
template <class Epi> __device__ __forceinline__ void run_gemm(unsigned char* smem, const bf16_t* A, const bf16_t* Bt, int M, int N, int K, const Epi& E) {
    pg8::Gemm g{A, Bt, M, N, K, K}; pg8::StaticOrder S; S.init(M, N, (int)gridDim.x, (int)blockIdx.x);
    pg8::gemm_phase<Epi, pg8::StaticOrder, false>((PG8_LAS unsigned char*)smem, g, S, E, nullptr);
}
static __device__ __forceinline__ void run_split(unsigned char* smem, const bf16_t* A, const bf16_t* Bt, int K, int ks, float* accb, int ld = 0, int kbase = 0) {
    if (ld == 0) ld = K;
    pg8::Gemm g{A, Bt, MP, D, ks, ld}; SplitOrder S{8 * (K / ks), (int)gridDim.x, (int)blockIdx.x, ks, kbase}; EpiAtomic E{accb};
    pg8::gemm_phase<EpiAtomic, SplitOrder, false>((PG8_LAS unsigned char*)smem, g, S, E, nullptr);
}

__global__ void __launch_bounds__(512) fwd_kernel(Params P) {
    extern __shared__ __attribute__((aligned(16))) unsigned char smem[];
    cg::grid_group grid = cg::this_grid();
    const int lo = P.ph_lo, hi = P.ph_hi;
    unsigned char* ws = P.ws;
    const int G = (int)gridDim.x, bx = (int)blockIdx.x;
#define PH(k) (lo <= (k) && (k) < hi)
    volatile LAS unsigned* xst = (volatile LAS unsigned*)(smem + 131072 + 512);
    if (threadIdx.x == 0) { xst[0] = 0u; xst[1] = 0u; }
    __syncthreads();
    const XcdBarrier xb = xcd_barrier_post((unsigned*)(ws + WS_BAR) + (size_t)P.li * XCD_BAR_WORDS, xst);
#define SEAM(k) do { if ((k) + 1 < hi) { if (P.pad == 77) grid.sync(); else xcd_barrier(xb); } } while (0)
    if (PH(0)) { { float* az = (float*)(ws + WS_ADA); for (size_t i = (size_t)bx * 512 + threadIdx.x; i < (size_t)132 * NADA; i += (size_t)G * 512) az[i] = 0.f; }
        { float* ab = (float*)(ws + WS_ACC); for (size_t i = (size_t)bx * 512 + threadIdx.x; i < (size_t)4 * NS * D; i += (size_t)G * 512) ab[i] = 0.f; }
        transpose_job(P.in[I_WADA], D, NADA, (bf16_t*)(ws + WS_RA), 1 << 30, 0, bx, G, (float*)smem); phase_misc0(P); SEAM(0); }
    if (PH(1)) {
        {
            pg8::Gemm g{(const bf16_t*)(ws + WS_AADA), (const bf16_t*)(ws + WS_RA), 256, NADA, 1024, D}; AdaOrder S{96, G, bx}; EpiAda E{(float*)(ws + WS_ADA), P.in[I_BADA]};
            pg8::gemm_phase<EpiAda, AdaOrder, false>((PG8_LAS unsigned char*)smem, g, S, E, nullptr); }
        const int first = G > 192 ? 96 : 0;
        if (bx >= first) { const int part = bx - first, np = G - first;
            transpose_job(P.in[I_WIN], D, 11552, (bf16_t*)(ws + WS_WIN), PRW, C_Q - PRW, part, np, (float*)smem);
            phase_misc1(P, (size_t)part * 512 + threadIdx.x, (size_t)np * 512); }
        SEAM(1); }
    if (PH(2)) { phase_modulate(P); SEAM(2); }
    if (PH(3)) { EpiBf16P E{(bf16_t*)(ws + WS_RA), NINP}; run_gemm(smem, (const bf16_t*)(ws + WS_RC), (const bf16_t*)(ws + WS_WIN), MP, NINP, D, E); SEAM(3); }
    if (PH(4)) { phase_lora_in(P); SEAM(4); }
    if (PH(5)) { float* dec = (float*)(ws + WS_RB); EpiLora E{dec, dec + (size_t)MP * RW, (bf16_t*)(dec + (size_t)2 * MP * RW), P.in[I_W0], P.in[I_A0]};
        {
            pg8::Gemm g{(const bf16_t*)(ws + WS_ALORA), (const bf16_t*)(ws + WS_WLORA), MP, NL, 256, KL}; LoraOrder S; S.init(MP, NL, G, bx);
            pg8::gemm_phase<EpiLora, LoraOrder, false>((PG8_LAS unsigned char*)smem, g, S, E, nullptr); }
        SEAM(5); }
    if (PH(7)) {
        if (G >= 192) {
            const int sel = P.pad;
            if (bx < 128) { if (sel == 0 || sel == 1) rwkv_prompt_item(P, bx, smem); }
            else if (bx < 160) { if (sel == 0 || sel == 2) ret_prompt_item(P, (bx - 128) >> 3, (bx - 128) & 7, smem); }
            else if (sel == 0 || sel == 3) { const int part = bx - 160, np = G - 160;
                for (int pr = part * 8 + (int)(threadIdx.x >> 6); pr < NS * 16; pr += np * 8) rwkv_sample_pair(P, pr);
                __syncthreads();
                for (int pr = part; pr < NS * 8; pr += np) ret_sample_pair(P, pr, smem);
                transpose_job(P.in[I_WBA], RW, D, (bf16_t*)(ws + WS_WBA), 1 << 30, 0, part, np, (float*)smem, D, 0);
                transpose_job(P.in[I_WBB], RW, D, (bf16_t*)(ws + WS_WBA), 1 << 30, 0, part, np, (float*)smem, D, RW);
                transpose_job(P.in[I_WOUT], D, D, (bf16_t*)(ws + WS_WOUT), 1 << 30, 0, part, np, (float*)smem);
                transpose_job(P.in[I_WUP], D, F2, (bf16_t*)(ws + WS_WUP), 1 << 30, 0, part, np, (float*)smem);
                transpose_job(P.in[I_WDOWN], DFF, D, (bf16_t*)(ws + WS_WDOWN), 1 << 30, 0, part, np, (float*)smem); }
        } else {
            for (int it = bx; it < 128; it += G) rwkv_prompt_item(P, it, smem);
            for (int it = bx; it < 32; it += G) ret_prompt_item(P, it >> 3, it & 7, smem);
            for (int pr = bx * 8 + (int)(threadIdx.x >> 6); pr < NS * 16; pr += G * 8) rwkv_sample_pair(P, pr);
            __syncthreads();
            for (int pr = bx; pr < NS * 8; pr += G) ret_sample_pair(P, pr, smem);
            transpose_job(P.in[I_WBA], RW, D, (bf16_t*)(ws + WS_WBA), 1 << 30, 0, bx, G, (float*)smem, D, 0);
            transpose_job(P.in[I_WBB], RW, D, (bf16_t*)(ws + WS_WBA), 1 << 30, 0, bx, G, (float*)smem, D, RW);
            transpose_job(P.in[I_WOUT], D, D, (bf16_t*)(ws + WS_WOUT), 1 << 30, 0, bx, G, (float*)smem);
            transpose_job(P.in[I_WUP], D, F2, (bf16_t*)(ws + WS_WUP), 1 << 30, 0, bx, G, (float*)smem);
            transpose_job(P.in[I_WDOWN], DFF, D, (bf16_t*)(ws + WS_WDOWN), 1 << 30, 0, bx, G, (float*)smem);
        }
        SEAM(7); }
    if (PH(8)) { phase_post(P); SEAM(8); }
    if (PH(9)) { const bf16_t* ya = (const bf16_t*)(ws + WS_RD);
        float* accb = (float*)(ws + WS_ACC);
        const bf16_t* wab = (const bf16_t*)(ws + WS_WBA);
        EpiMerged EM{(const bf16_t*)(ws + WS_RA), (bf16_t*)(ws + WS_RC)}; run_gemm(smem, ya, wab, MPR, D, D, EM);
        run_split(smem, ya, wab, RW, 256, accb, D, 0);
        run_split(smem, ya, wab, RW, 256, accb + (size_t)NS * D, D, RW);
        xcd_barrier(xb);
        {
            const bf16_t* proj = (const bf16_t*)(ws + WS_RA); bf16_t* mg = (bf16_t*)(ws + WS_RC);
            for (size_t i = (size_t)bx * 512 + threadIdx.x; i < (size_t)256 * D; i += (size_t)G * 512) { const int r = (int)(i >> 11), cc = (int)(i & (D - 1)); float v = 0.f;
                if (r < NS) { const size_t row = (size_t)MPR + r; v = sigmoidf_(bf2f(proj[row * NINP + C_GA + cc])) * accb[(size_t)r * D + cc] + sigmoidf_(bf2f(proj[row * NINP + C_GB + cc])) * accb[(size_t)(NS + r) * D + cc]; }
                mg[((size_t)MPR + r) * D + cc] = f2bf(v); } }
        SEAM(9); }
    if (PH(10)) { EpiRes<0> E{P.in[I_XP], (const float*)(ws + WS_ADA), (bf16_t*)(ws + WS_RD), P.out}; run_gemm(smem, (const bf16_t*)(ws + WS_RC), (const bf16_t*)(ws + WS_WOUT), MPR, D, D, E);
        run_split(smem, (const bf16_t*)(ws + WS_RC), (const bf16_t*)(ws + WS_WOUT), D, 256, (float*)(ws + WS_ACC) + (size_t)2 * NS * D); SEAM(10); }
    if (PH(11)) { phase_ln<0>(P); SEAM(11); }
    if (PH(12)) { EpiUp E{(bf16_t*)(ws + WS_RA), P.out}; run_gemm(smem, (const bf16_t*)(ws + WS_RC), (const bf16_t*)(ws + WS_WUP), MP, F2, D, E); SEAM(12); }
    if (PH(13)) { phase_conv(P); SEAM(13); }
    if (PH(14)) { EpiRes<1> E{P.in[I_XP], (const float*)(ws + WS_ADA), (bf16_t*)(ws + WS_RD), P.out}; run_gemm(smem, (const bf16_t*)(ws + WS_RB), (const bf16_t*)(ws + WS_WDOWN), MPR, D, DFF, E);
        run_split(smem, (const bf16_t*)(ws + WS_RB), (const bf16_t*)(ws + WS_WDOWN), DFF, 256, (float*)(ws + WS_ACC) + (size_t)3 * NS * D); SEAM(14); }
    if (PH(15)) { phase_ln<1>(P); }
#undef PH
#undef SEAM
}

extern "C" void kernel_launch(void* const* d_in, const int* in_sizes, int n_in, void* d_out, int out_size, void* d_ws, size_t ws_size, hipStream_t stream) {
    static int grid = 0;
    if (grid == 0) {
        if (n_in != 35 || (size_t)out_size != O_END || ws_size < WS_END) { fprintf(stderr, "kernel_launch: unexpected shapes: n_in %d out %d ws %zu (need %zu)\n", n_in, out_size, ws_size, (size_t)WS_END); grid = -1; return; }
        int dev = 0, cus = 0, per_cu = 0;
        hipGetDevice(&dev); hipDeviceGetAttribute(&cus, hipDeviceAttributeMultiprocessorCount, dev);
        if (hipFuncSetAttribute((const void*)fwd_kernel, hipFuncAttributeMaxDynamicSharedMemorySize, LDS_BYTES) != hipSuccess) { fprintf(stderr, "kernel_launch: hipFuncSetAttribute failed\n"); grid = -1; return; }
        if (hipOccupancyMaxActiveBlocksPerMultiprocessor(&per_cu, (const void*)fwd_kernel, 512, LDS_BYTES) != hipSuccess || per_cu < 1) { fprintf(stderr, "kernel_launch: occupancy query failed (%d)\n", per_cu); (void)hipGetLastError(); per_cu = 1; }
        grid = cus * 1;
        if (grid <= 0) { grid = -1; return; }
    }
    if (grid < 0) return;
    if (hipMemsetAsync((unsigned char*)d_ws + WS_BAR, 0, (size_t)4 * XCD_BAR_WORDS * 4, stream) != hipSuccess) { fprintf(stderr, "kernel_launch: memset of the barrier words failed\n"); return; }
    Params p{};
    for (int i = 0; i < 35; ++i) p.in[i] = (const float*)d_in[i];
    p.out = (float*)d_out; p.ws = (unsigned char*)d_ws;
#if MULTI
    for (int ph = 0; ph <= NPHASE; ++ph) { p.ph_lo = ph; p.ph_hi = ph + 1; hipLaunchKernelGGL(fwd_kernel, dim3(grid), dim3(512), LDS_BYTES, stream, p); }
#else
    void* args[] = {&p};
#if DUPK >= 0
    p.ph_lo = 0; p.ph_hi = DUPK + 1;
    (void)hipLaunchCooperativeKernel((const void*)fwd_kernel, dim3(grid), dim3(512), args, LDS_BYTES, stream);
    p.ph_lo = DUPK; p.ph_hi = NPHASE + 1; p.li = 1;
#ifdef DUPSEL
    p.ph_lo = 7; p.ph_hi = 8; p.pad = DUPSEL;
    (void)hipLaunchCooperativeKernel((const void*)fwd_kernel, dim3(grid), dim3(512), args, LDS_BYTES, stream);
    p.ph_lo = 8; p.ph_hi = NPHASE + 1; p.pad = 0; p.li = 2;
#endif
    (void)hipLaunchCooperativeKernel((const void*)fwd_kernel, dim3(grid), dim3(512), args, LDS_BYTES, stream);
#else
    p.ph_lo = 0; p.ph_hi = NPHASE + 1;
    hipError_t e = hipLaunchCooperativeKernel((const void*)fwd_kernel, dim3(grid), dim3(512), args, LDS_BYTES, stream);
    if (e != hipSuccess) fprintf(stderr, "cooperative launch failed: %s (grid %d)\n", hipGetErrorString(e), grid);
#endif
#endif
}
```
